# Optimizing an MI355X kernel written in HIP

```python
import math
import functools
import jax
import jax.numpy as jnp
from jax import lax
import numpy as np

D_MODEL = 1024
BATCH = 4
SEQ = 4096
DEPTH = 2

CTX_LEN = 256
GRID_W = 64
EPS = 1e-6
N_DIR = 2
CHUNK = 64

GDN_HEADS = D_MODEL // 256
GDN_DK = 128
GDN_DV = 128
CONV_W = 3

MLSTM_HEADS = D_MODEL // 256
MLSTM_DK = 128
MLSTM_DV = 128

RET_HEADS = D_MODEL // 128
RET_DK = 128
RET_DV = 256
ROPE_BASE = 10000.0

N_EXPERTS = 32
TOP_K = 4
D_FF = D_MODEL
SWIGLU_ALPHA = 1.702
SWIGLU_LIMIT = 7.0
MOE_BLOCK = 256

GDN_QK_W = GDN_HEADS * GDN_DK
GDN_V_W = GDN_HEADS * GDN_DV
GDN_CONV_CH = 2 * GDN_QK_W + GDN_V_W
ML_QK_W = MLSTM_HEADS * MLSTM_DK
ML_V_W = MLSTM_HEADS * MLSTM_DV
EVEN_SPLITS = (GDN_CONV_CH, GDN_V_W, N_DIR * GDN_HEADS, N_DIR * GDN_HEADS,
               ML_QK_W, ML_QK_W, ML_V_W, ML_V_W, N_DIR * MLSTM_HEADS, N_DIR * MLSTM_HEADS)
EVEN_IN = sum(EVEN_SPLITS)
EVEN_OUT = GDN_V_W + ML_V_W
RET_QK_W = RET_HEADS * RET_DK
RET_V_W = RET_HEADS * RET_DV
ODD_SPLITS = (RET_QK_W, RET_QK_W, RET_V_W, RET_V_W)
ODD_IN = sum(ODD_SPLITS)
N_EVEN = (DEPTH + 1) // 2
N_ODD = DEPTH // 2

kernel_name = 'hybrid_gdn_mlstm_retention_moe_dit'


def rms_norm(x, g):
    xf = x.astype(jnp.float32)
    y = xf * lax.rsqrt(jnp.mean(xf * xf, axis=-1, keepdims=True) + EPS)
    return (y * g.astype(jnp.float32)).astype(x.dtype)


def modulate(h, shift, scale):
    return h * (1.0 + scale) + shift


def ada_modulation(cond, w_mod, b_mod):
    m = jax.nn.silu(cond) @ w_mod + b_mod
    return jnp.split(m[:, None, :], 6, axis=-1)


def split_cols(t, sizes):
    bounds = []
    acc = 0
    for s_ in sizes[:-1]:
        acc += s_
        bounds.append(acc)
    return jnp.split(t, bounds, axis=-1)


def to_heads(t, heads):
    b, n, _ = t.shape
    return jnp.swapaxes(t.reshape(b, n, heads, -1), 1, 2).astype(jnp.float32)


def dir_gates(t, heads):
    b, n, _ = t.shape
    return jnp.transpose(t.reshape(b, n, N_DIR, heads), (2, 0, 3, 1)).astype(jnp.float32)


def l2_normalize(t):
    return t * lax.rsqrt(jnp.sum(t * t, axis=-1, keepdims=True) + EPS)


def headwise_norm(o, gain, center=False):
    o = jnp.swapaxes(o, 1, 2)
    if center:
        o = o - jnp.mean(o, axis=-1, keepdims=True)
    o = o * lax.rsqrt(jnp.mean(o * o, axis=-1, keepdims=True) + EPS) * gain.astype(jnp.float32)
    return o.reshape(o.shape[0], o.shape[1], -1)


def centred_short_conv(u, w, on_grid):
    b, t, ch = u.shape
    if on_grid:
        rows = t // GRID_W
        u = u.reshape(b, rows, GRID_W, ch)
    n = u.shape[-2]
    pad = CONV_W // 2
    up = jnp.pad(u, [(0, 0)] * (u.ndim - 2) + [(pad, pad), (0, 0)])
    y = up[..., 0:n, :] * w[0]
    for j in range(1, CONV_W):
        y = y + up[..., j:j + n, :] * w[j]
    return jax.nn.silu(y).reshape(b, t, ch)


def rope(t, pos):
    half = t.shape[-1] // 2
    freqs = ROPE_BASE ** (-jnp.arange(half, dtype=jnp.float32) / half)
    ang = pos[:, None] * freqs[None, :]
    cos, sin = jnp.cos(ang), jnp.sin(ang)
    t1, t2 = t[..., :half], t[..., half:]
    return jnp.concatenate([t1 * cos - t2 * sin, t1 * sin + t2 * cos], axis=-1)


def to_chunks(t):
    b, h, n = t.shape[:3]
    t = t.reshape(b, h, n // CHUNK, CHUNK, *t.shape[3:])
    return jnp.moveaxis(t, 2, 0)


def from_chunks(o):
    o = jnp.moveaxis(o, 0, 2)
    return o.reshape(o.shape[0], o.shape[1], -1, o.shape[-1])


def gdn_chunk_scan(q, k, v, log_alpha, beta, state):
    q, k, v, log_alpha, beta = (to_chunks(t) for t in (q, k, v, log_alpha, beta))
    dv = v.shape[-1]
    g = jnp.cumsum(log_alpha, axis=-1)
    idx = jnp.arange(CHUNK)
    incl = idx[:, None] >= idx[None, :]
    strict = idx[:, None] > idx[None, :]
    decay = jnp.exp(jnp.where(incl, g[..., :, None] - g[..., None, :], -jnp.inf))
    k_beta = k * beta[..., None]
    lower = jnp.where(strict, jnp.einsum('nbhcd,nbhsd->nbhcs', k_beta, k) * decay, 0.0)
    rhs = jnp.concatenate([v * beta[..., None], k_beta * jnp.exp(g)[..., None]], axis=-1)
    sol = lax.linalg.triangular_solve(lower, rhs, left_side=True, lower=True, unit_diagonal=True)
    u, w = sol[..., :dv], sol[..., dv:]
    qk = jnp.where(incl, jnp.einsum('nbhcd,nbhsd->nbhcs', q, k) * decay, 0.0)
    q_dec = q * jnp.exp(g)[..., None]
    k_dec = k * jnp.exp(g[..., -1:] - g)[..., None]
    chunk_decay = jnp.exp(g[..., -1])

    def step(s, xs):
        u_c, w_c, qk_c, qd_c, kd_c, cd_c = xs
        v_new = u_c - jnp.einsum('bhcd,bhde->bhce', w_c, s)
        o = jnp.einsum('bhcd,bhde->bhce', qd_c, s) + jnp.einsum('bhcs,bhse->bhce', qk_c, v_new)
        s = s * cd_c[..., None, None] + jnp.einsum('bhcd,bhce->bhde', kd_c, v_new)
        return s, o

    s_fin, o = lax.scan(step, state, (u, w, qk, q_dec, k_dec, chunk_decay))
    return from_chunks(o), s_fin


def mlstm_chunk_scan(q, k, v, log_i, log_f, state):
    q, k, v, log_i, log_f = (to_chunks(t) for t in (q, k, v, log_i, log_f))
    idx = jnp.arange(CHUNK)
    incl = idx[:, None] >= idx[None, :]

    def step(carry, xs):
        c, n, m = carry
        qc, kc, vc, ic, fc = xs
        b = jnp.cumsum(fc, axis=-1)
        d_in = jnp.where(incl, b[..., :, None] - b[..., None, :] + ic[..., None, :], -jnp.inf)
        d_carry = b + m[..., None]
        m_t = jnp.maximum(d_carry, jnp.max(d_in, axis=-1))
        s = jnp.einsum('bhcd,bhsd->bhcs', qc, kc) * jnp.exp(d_in - m_t[..., None])
        w_carry = jnp.exp(d_carry - m_t)
        num = w_carry[..., None] * jnp.einsum('bhcd,bhde->bhce', qc, c) + jnp.einsum('bhcs,bhse->bhce', s, vc)
        den = w_carry * jnp.einsum('bhcd,bhd->bhc', qc, n) + jnp.sum(s, axis=-1)
        h = num / jnp.maximum(jnp.abs(den), jnp.exp(-m_t))[..., None]
        d_end = b[..., -1:] - b + ic
        carry_end = b[..., -1] + m
        m_new = jnp.maximum(carry_end, jnp.max(d_end, axis=-1))
        w_end = jnp.exp(d_end - m_new[..., None])
        f_end = jnp.exp(carry_end - m_new)
        c = f_end[..., None, None] * c + jnp.einsum('bhs,bhsd,bhse->bhde', w_end, kc, vc)
        n = f_end[..., None] * n + jnp.einsum('bhs,bhsd->bhd', w_end, kc)
        return (c, n, m_new), h

    state, h = lax.scan(step, state, (q, k, v, log_i, log_f))
    return from_chunks(h), state


def retention_chunk_scan(q, k, v, state, log_gamma):
    q, k, v = (to_chunks(t) for t in (q, k, v))
    pos = jnp.arange(CHUNK, dtype=jnp.float32)
    lg = log_gamma[:, None]
    diff = pos[:, None] - pos[None, :]
    intra = jnp.exp(jnp.where(diff >= 0, diff * lg[..., None], -jnp.inf))
    cross = jnp.exp((pos + 1.0) * lg)
    tail = jnp.exp((CHUNK - 1.0 - pos) * lg)
    chunk_decay = jnp.exp(CHUNK * log_gamma)

    def step(s, xs):
        qc, kc, vc = xs
        scores = jnp.einsum('bhcd,bhsd->bhcs', qc, kc) * intra
        o = jnp.einsum('bhcs,bhse->bhce', scores, vc) + jnp.einsum('bhcd,bhde->bhce', qc, s) * cross[..., None]
        s = chunk_decay[:, None, None] * s + jnp.einsum('bhsd,bhse->bhde', kc * tail[..., None], vc)
        return s, o

    s_fin, o = lax.scan(step, state, (q, k, v))
    return from_chunks(o), s_fin


def retention_log_decay(reverse):
    expo = 5.0 + jnp.arange(RET_HEADS, dtype=jnp.float32)
    if reverse:
        expo = expo[::-1]
    return jnp.log1p(-jnp.exp2(-expo))


def bidirectional_scan(scan_f, scan_b, ctx_f, lat_f, ctx_b, lat_b, state0):
    def run(fn, ctx_seq, lat_seq):
        o_ctx, s_ctx = fn(*ctx_seq, state0)
        o_lat, _ = fn(*lat_seq, s_ctx)
        return o_ctx, o_lat

    def rev(seq):
        return tuple(jnp.flip(t, axis=2) for t in seq)

    cf, lf = run(scan_f, ctx_f, lat_f)
    cb, lb = run(scan_b, rev(ctx_b), rev(lat_b))
    return cf + jnp.flip(cb, axis=2), lf + jnp.flip(lb, axis=2)


def gdn_mlstm_mixer(h_ctx, h_lat, w_in, conv_w, a_log, dt_bias, gdn_g, i_bias, f_bias, ml_g, w_out, last):
    f32 = jnp.float32
    a_rate = jnp.exp(a_log.astype(f32))[:, None, :, None]
    dt_b = dt_bias.astype(f32)[:, None, :, None]
    i_b = i_bias.astype(f32)[:, None, :, None]
    f_b = f_bias.astype(f32)[:, None, :, None]

    def prepare(h, on_grid):
        qkv, z, a_gate, b_gate, mq, mk, mv, mo, i_gate, f_gate = split_cols(h @ w_in, EVEN_SPLITS)
        qkv = centred_short_conv(qkv, conv_w, on_grid)
        aq, ak, av = split_cols(qkv, (GDN_QK_W, GDN_QK_W, GDN_V_W))
        aq = l2_normalize(to_heads(aq, GDN_HEADS)) * GDN_DK ** -0.5
        ak = l2_normalize(to_heads(ak, GDN_HEADS))
        av = to_heads(av, GDN_HEADS)
        log_alpha = -a_rate * jax.nn.softplus(dir_gates(a_gate, GDN_HEADS) + dt_b)
        beta = jax.nn.sigmoid(dir_gates(b_gate, GDN_HEADS))
        mq = to_heads(mq, MLSTM_HEADS)
        mk = to_heads(mk, MLSTM_HEADS) * MLSTM_DK ** -0.5
        mv = to_heads(mv, MLSTM_HEADS)
        log_i = dir_gates(i_gate, MLSTM_HEADS) + i_b
        log_f = jax.nn.log_sigmoid(dir_gates(f_gate, MLSTM_HEADS) + f_b)
        gdn_seq = tuple((aq, ak, av, log_alpha[d], beta[d]) for d in range(N_DIR))
        ml_seq = tuple((mq, mk, mv, log_i[d], log_f[d]) for d in range(N_DIR))
        return gdn_seq, ml_seq, z, mo

    ctx_gdn, ctx_ml, ctx_z, ctx_o = prepare(h_ctx, False)
    lat_gdn, lat_ml, lat_z, lat_o = prepare(h_lat, True)
    b = h_lat.shape[0]
    gdn_s0 = jnp.zeros((b, GDN_HEADS, GDN_DK, GDN_DV), f32)
    ml_s0 = (jnp.zeros((b, MLSTM_HEADS, MLSTM_DK, MLSTM_DV), f32),
             jnp.zeros((b, MLSTM_HEADS, MLSTM_DK), f32),
             jnp.zeros((b, MLSTM_HEADS), f32))
    gdn_c, gdn_l = bidirectional_scan(gdn_chunk_scan, gdn_chunk_scan,
                                      ctx_gdn[0], lat_gdn[0], ctx_gdn[1], lat_gdn[1], gdn_s0)
    ml_c, ml_l = bidirectional_scan(mlstm_chunk_scan, mlstm_chunk_scan,
                                    ctx_ml[0], lat_ml[0], ctx_ml[1], lat_ml[1], ml_s0)

    def merge(o_gdn, o_ml, z, og, dtype):
        a = headwise_norm(o_gdn, gdn_g) * jax.nn.silu(z.astype(f32))
        m = headwise_norm(o_ml, ml_g.reshape(MLSTM_HEADS, MLSTM_DV)) * jax.nn.sigmoid(og.astype(f32))
        return jnp.concatenate([a, m], axis=-1).astype(dtype) @ w_out

    y_lat = merge(gdn_l, ml_l, lat_z, lat_o, h_lat.dtype)
    y_ctx = None if last else merge(gdn_c, ml_c, ctx_z, ctx_o, h_ctx.dtype)
    return y_ctx, y_lat


def retention_mixer(h_ctx, h_lat, pos_ctx, pos_lat, w_in, norm_g, w_out, last):
    def prepare(h, pos):
        q, k, v, g = split_cols(h @ w_in, ODD_SPLITS)
        q = rope(to_heads(q, RET_HEADS), pos)
        k = rope(to_heads(k, RET_HEADS), pos) * RET_DK ** -0.5
        return (q, k, to_heads(v, RET_HEADS)), g

    ctx_seq, ctx_g = prepare(h_ctx, pos_ctx)
    lat_seq, lat_g = prepare(h_lat, pos_lat)
    s0 = jnp.zeros((h_lat.shape[0], RET_HEADS, RET_DK, RET_DV), jnp.float32)
    scan_f = functools.partial(retention_chunk_scan, log_gamma=retention_log_decay(False))
    scan_b = functools.partial(retention_chunk_scan, log_gamma=retention_log_decay(True))
    o_ctx, o_lat = bidirectional_scan(scan_f, scan_b, ctx_seq, lat_seq, ctx_seq, lat_seq, s0)

    def merge(o, g, dtype):
        y = headwise_norm(o, norm_g.reshape(RET_HEADS, RET_DV), center=True) * jax.nn.silu(g.astype(jnp.float32))
        return y.astype(dtype) @ w_out

    y_lat = merge(o_lat, lat_g, h_lat.dtype)
    y_ctx = None if last else merge(o_ctx, ctx_g, h_ctx.dtype)
    return y_ctx, y_lat


def moe_ffn(h, router_w, router_b, w_gu, b_gu, w_dn, b_dn):
    n, d = h.shape
    logits = (h @ router_w + router_b).astype(jnp.float32)
    top_val, top_idx = lax.top_k(logits, TOP_K)
    top_w = jax.nn.softmax(top_val, axis=-1)
    n_assign = n * TOP_K
    n_blocks = -(-n_assign // MOE_BLOCK) + N_EXPERTS
    flat_e = top_idx.reshape(-1)
    order = jnp.argsort(flat_e)
    sorted_e = flat_e[order]
    counts = jnp.bincount(flat_e, length=N_EXPERTS)
    padded = -(-counts // MOE_BLOCK) * MOE_BLOCK
    ends = jnp.cumsum(padded)
    dest = (ends - padded)[sorted_e] + jnp.arange(n_assign) - (jnp.cumsum(counts) - counts)[sorted_e]
    rows = n_blocks * MOE_BLOCK
    row_tok = jnp.zeros((rows,), jnp.int32).at[dest].set((order // TOP_K).astype(jnp.int32))
    row_w = jnp.zeros((rows,), jnp.float32).at[dest].set(top_w.reshape(-1)[order])
    block_e = jnp.minimum(jnp.searchsorted(ends, jnp.arange(n_blocks) * MOE_BLOCK, side='right'), N_EXPERTS - 1)

    def block_step(acc, xs):
        tok, wt, e = xs
        gu = h[tok] @ w_gu[e] + b_gu[e]
        gate = jnp.minimum(gu[:, 0::2], SWIGLU_LIMIT)
        up = jnp.clip(gu[:, 1::2], -SWIGLU_LIMIT, SWIGLU_LIMIT)
        act = (up + 1.0) * gate * jax.nn.sigmoid(SWIGLU_ALPHA * gate)
        y = act @ w_dn[e] + b_dn[e]
        return acc.at[tok].add(y * wt[:, None].astype(y.dtype)), None

    out, _ = lax.scan(block_step, jnp.zeros_like(h),
                      (row_tok.reshape(n_blocks, MOE_BLOCK), row_w.reshape(n_blocks, MOE_BLOCK), block_e))
    return out


def setup_inputs(seed: int = 0) -> dict:
    key = jax.random.key(seed)
    ks = iter(jax.random.split(key, 32))
    f32 = jnp.float32

    def nrm(shape, scale):
        return jax.random.normal(next(ks), shape, f32) * scale

    x = nrm((BATCH, SEQ, D_MODEL), 1.0)
    c = nrm((BATCH, D_MODEL), 1.0)
    ctx = nrm((BATCH, CTX_LEN, D_MODEL), 1.0)
    c_ctx = nrm((D_MODEL,), 1.0)
    mod_w = nrm((DEPTH, D_MODEL, 6 * D_MODEL), 0.5 * D_MODEL ** -0.5)
    mod_b = nrm((DEPTH, 6 * D_MODEL), 0.02)
    norm1_g = 1.0 + nrm((DEPTH, D_MODEL), 0.02)
    norm2_g = 1.0 + nrm((DEPTH, D_MODEL), 0.02)
    ev_w_in = nrm((N_EVEN, D_MODEL, EVEN_IN), D_MODEL ** -0.5)
    ev_conv_w = nrm((N_EVEN, CONV_W, GDN_CONV_CH), CONV_W ** -0.5)
    gdn_a_log = jnp.log(jax.random.uniform(next(ks), (N_EVEN, N_DIR, GDN_HEADS), f32, 1.0, 16.0))
    dt = jnp.exp(jax.random.uniform(next(ks), (N_EVEN, N_DIR, GDN_HEADS), f32, math.log(1e-3), math.log(1e-1)))
    gdn_dt_bias = dt + jnp.log(-jnp.expm1(-dt))
    gdn_norm_g = 1.0 + nrm((N_EVEN, GDN_DV), 0.02)
    ml_i_bias = nrm((N_EVEN, N_DIR, MLSTM_HEADS), 0.1)
    ml_f_bias = jnp.linspace(3.0, 6.0, MLSTM_HEADS, dtype=f32) + nrm((N_EVEN, N_DIR, MLSTM_HEADS), 0.1)
    ml_norm_g = 1.0 + nrm((N_EVEN, ML_V_W), 0.02)
    ev_w_out = nrm((N_EVEN, EVEN_OUT, D_MODEL), EVEN_OUT ** -0.5)
    od_w_in = nrm((N_ODD, D_MODEL, ODD_IN), D_MODEL ** -0.5)
    ret_norm_g = 1.0 + nrm((N_ODD, RET_V_W), 0.02)
    od_w_out = nrm((N_ODD, RET_V_W, D_MODEL), RET_V_W ** -0.5)
    router_w = nrm((DEPTH, D_MODEL, N_EXPERTS), D_MODEL ** -0.5)
    router_b = nrm((DEPTH, N_EXPERTS), 0.01)
    moe_w_gu = nrm((DEPTH, N_EXPERTS, D_MODEL, 2 * D_FF), D_MODEL ** -0.5)
    moe_b_gu = nrm((DEPTH, N_EXPERTS, 2 * D_FF), 0.02)
    moe_w_dn = nrm((DEPTH, N_EXPERTS, D_FF, D_MODEL), D_FF ** -0.5)
    moe_b_dn = nrm((DEPTH, N_EXPERTS, D_MODEL), 0.02)
    final_g = 1.0 + nrm((D_MODEL,), 0.02)
    return {'x': x, 'c': c, 'ctx': ctx, 'c_ctx': c_ctx, 'mod_w': mod_w, 'mod_b': mod_b,
            'norm1_g': norm1_g, 'norm2_g': norm2_g, 'ev_w_in': ev_w_in, 'ev_conv_w': ev_conv_w,
            'gdn_a_log': gdn_a_log, 'gdn_dt_bias': gdn_dt_bias, 'gdn_norm_g': gdn_norm_g,
            'ml_i_bias': ml_i_bias, 'ml_f_bias': ml_f_bias, 'ml_norm_g': ml_norm_g, 'ev_w_out': ev_w_out,
            'od_w_in': od_w_in, 'ret_norm_g': ret_norm_g, 'od_w_out': od_w_out,
            'router_w': router_w, 'router_b': router_b, 'moe_w_gu': moe_w_gu, 'moe_b_gu': moe_b_gu,
            'moe_w_dn': moe_w_dn, 'moe_b_dn': moe_b_dn, 'final_g': final_g}


def reference(x, c, ctx, c_ctx, mod_w, mod_b, norm1_g, norm2_g, ev_w_in, ev_conv_w, gdn_a_log, gdn_dt_bias,
              gdn_norm_g, ml_i_bias, ml_f_bias, ml_norm_g, ev_w_out, od_w_in, ret_norm_g, od_w_out,
              router_w, router_b, moe_w_gu, moe_b_gu, moe_w_dn, moe_b_dn, final_g):
    b, s, d = x.shape
    n_ctx_tok = ctx.shape[1]
    pos_ctx = jnp.arange(n_ctx_tok, dtype=jnp.float32)
    pos_lat = n_ctx_tok + jnp.arange(s, dtype=jnp.float32)
    x_lat, x_ctx = x, ctx
    for layer in range(DEPTH):
        last = layer == DEPTH - 1
        j = layer // 2
        sh1, sc1, g1, sh2, sc2, g2 = ada_modulation(c, mod_w[layer], mod_b[layer])
        csh1, csc1, cg1, csh2, csc2, cg2 = ada_modulation(c_ctx[None, :], mod_w[layer], mod_b[layer])
        h_lat = modulate(rms_norm(x_lat, norm1_g[layer]), sh1, sc1)
        h_ctx = modulate(rms_norm(x_ctx, norm1_g[layer]), csh1, csc1)
        if layer % 2 == 0:
            y_ctx, y_lat = gdn_mlstm_mixer(h_ctx, h_lat, ev_w_in[j], ev_conv_w[j], gdn_a_log[j], gdn_dt_bias[j],
                                           gdn_norm_g[j], ml_i_bias[j], ml_f_bias[j], ml_norm_g[j],
                                           ev_w_out[j], last)
        else:
            y_ctx, y_lat = retention_mixer(h_ctx, h_lat, pos_ctx, pos_lat, od_w_in[j], ret_norm_g[j],
                                           od_w_out[j], last)
        x_lat = x_lat + g1 * y_lat
        h_lat = modulate(rms_norm(x_lat, norm2_g[layer]), sh2, sc2)
        moe_params = (router_w[layer], router_b[layer], moe_w_gu[layer], moe_b_gu[layer],
                      moe_w_dn[layer], moe_b_dn[layer])
        if last:
            x_lat = x_lat + g2 * moe_ffn(h_lat.reshape(-1, d), *moe_params).reshape(b, s, d)
        else:
            x_ctx = x_ctx + cg1 * y_ctx
            h_ctx = modulate(rms_norm(x_ctx, norm2_g[layer]), csh2, csc2)
            tokens = jnp.concatenate([h_ctx.reshape(-1, d), h_lat.reshape(-1, d)], axis=0)
            out = moe_ffn(tokens, *moe_params)
            n_c = b * n_ctx_tok
            x_ctx = x_ctx + cg2 * out[:n_c].reshape(b, n_ctx_tok, d)
            x_lat = x_lat + g2 * out[n_c:].reshape(b, s, d)
    return rms_norm(x_lat, final_g)
```

```cpp
#include <hip/hip_runtime.h>
#include <cstdio>
#include <cstdint>
constexpr int LDS_WAVETAB = 131072 + 2048;
__device__ __forceinline__ int tid_fresh() {
    extern __shared__ __attribute__((aligned(16))) unsigned char lds_raw_t[];
    int z; asm volatile("v_mov_b32 %0, 0" : "=v"(z));
    const int lane = (int)__builtin_amdgcn_mbcnt_hi(~0u, __builtin_amdgcn_mbcnt_lo(~0u, (unsigned)z));
    const unsigned hw = (unsigned)__builtin_amdgcn_s_getreg((5 << 11) | 4) & 63u;
    const int wv = __builtin_amdgcn_readfirstlane(*(volatile __attribute__((address_space(3))) int*)((__attribute__((address_space(3))) unsigned char*)lds_raw_t + LDS_WAVETAB + 4 * hw));
    int t = wv * 64 + lane; asm volatile("" : "+v"(t)); return t;
}
namespace pg8 {
#define PG8_LAS __attribute__((address_space(3)))
typedef unsigned short bf16_t;
typedef short bf16x8 __attribute__((ext_vector_type(8)));
typedef float f32x4 __attribute__((ext_vector_type(4)));
typedef unsigned u32x4 __attribute__((ext_vector_type(4)));
constexpr int BM = 256, BK = 64, HALF = 128, HTB = HALF * BK * 2  , STAGE_BYTES = 8 * HTB, NXCD = 8, WGM = 8;

__host__ __device__ __forceinline__ int lds_byte(int r, int c) { const int st = (r >> 4) * 2 + (c >> 5), rr = r & 15, cc = c & 31, ob = rr * 64 + cc * 2; return st * 1024 + (ob ^ (((ob >> 9) & 1) << 5)); }
__host__ __device__ __forceinline__ void stage_rc(int b, int& R, int& C) { const int st = b / 1024, sb = b % 1024, swz = sb ^ (((sb >> 9) & 1) << 5); R = (st >> 1) * 16 + swz / 64; C = (st & 1) * 32 + (swz % 64) / 2; }
__host__ __device__ __forceinline__ int perm32(int rho) { const int n = rho >> 4, i = rho & 15; return 8 * (i >> 2) + 4 * n + (i & 3); }

struct Unit { int pm, pn; };
struct Gemm { const bf16_t* A; const bf16_t* Bt; int M, N, K; };

struct StaticOrder {
    int nM, nN, nwg, G, c;
    __host__ __device__ void init(int M, int N, int G_, int c_) { nM = M / BM; nN = N / BM; nwg = nM * nN; G = G_; c = c_; }
    __host__ __device__ bool next(int i, Unit& u) const {
        const long L = (long)i * G + c; if (L >= nwg) return false;
        int wgid = (int)L; { const int q = nwg / NXCD, r = nwg % NXCD, xcd = wgid % NXCD, off = wgid / NXCD; wgid = (xcd < r ? xcd * (q + 1) : r * (q + 1) + (xcd - r) * q) + off; }
        const int nig = WGM * nN, gid = wgid / nig, fm = gid * WGM, gsz = (nM - fm) < WGM ? (nM - fm) : WGM;
        u.pm = fm + ((wgid % nig) % gsz); u.pn = (wgid % nig) / gsz; return true;
    }
    __device__ __forceinline__ void a_ready(const Unit&) const {}
    __device__ __forceinline__ void done(const Unit&) const {}
};

__device__ __forceinline__ unsigned cvt_pk_bf16(float lo, float hi) { unsigned r; asm volatile("v_cvt_pk_bf16_f32 %0, %1, %2" : "=v"(r) : "v"(lo), "v"(hi)); return r; }
typedef float f32x2 __attribute__((ext_vector_type(2)));
__device__ __forceinline__ f32x2 gelu_pk(f32x2 v) {
    const f32x2 av = __builtin_elementwise_abs(v), d = av * 0.2316418882f + 1.0f;
    f32x2 t; t.x = __builtin_amdgcn_rcpf(d.x); t.y = __builtin_amdgcn_rcpf(d.y);
    f32x2 q = t * 0.5307027145f + (-0.7265760135f); q = q * t + 0.7107068705f; q = q * t + (-0.142248368f); q = q * t + 0.127414796f; q = q * t;
    const f32x2 s = (v * v) * (-0.72134752044f);
    f32x2 e; e.x = __builtin_amdgcn_exp2f(s.x); e.y = __builtin_amdgcn_exp2f(s.y);
    const f32x2 m = v * (q * e), r = v - m;
    f32x2 o; o.x = v.x < 0.f ? m.x : r.x; o.y = v.y < 0.f ? m.y : r.y; return o;
}

template <int ACT  > struct EpiBf16 {
    static constexpr bool PERM = true, AFTER_DRAIN = false, LDS_BIAS = false; static_assert(ACT == 0 || ACT == 1, "EpiBf16: ACT is 0 (none) or 1 (gelu_pk)");
    bf16_t* O; int ldc; const float* bias; int split_cols; size_t split_stride; float scale0;
    __device__ __forceinline__ void operator()(const f32x4 (&acc)[2][2][4][2], const Unit& u, int wr, int wc, int fr, int fq) const {
        const int row0 = u.pm * BM + wr * 64 + fr; int colt = u.pn * BM; bf16_t* base = O;
        float sc = 1.f; if (split_cols) { const int t = colt / split_cols; base += (size_t)t * split_stride; colt -= t * split_cols; if (t == 0) sc = scale0; }
        const int col0 = colt + wc * 32 + 8 * fq, bcol0 = u.pn * BM + wc * 32 + 8 * fq;
        f32x4 bv[2][2];
#pragma unroll
        for (int bj = 0; bj < 2; ++bj)
#pragma unroll
            for (int n = 0; n < 2; ++n) bv[bj][n] = bias ? *(const f32x4*)(bias + bcol0 + bj * HALF + 4 * n) : (f32x4){0.f, 0.f, 0.f, 0.f};
#pragma unroll
        for (int ai = 0; ai < 2; ++ai)
#pragma unroll
            for (int m = 0; m < 4; ++m) { bf16_t* rowp = base + (size_t)(row0 + ai * HALF + m * 16) * ldc + col0;
#pragma unroll
                for (int bj = 0; bj < 2; ++bj) { f32x4 v0 = acc[ai][bj][m][0] + bv[bj][0], v1 = acc[ai][bj][m][1] + bv[bj][1];
                    if (ACT == 1) { f32x2 a = gelu_pk((f32x2){v0[0], v0[1]}), b = gelu_pk((f32x2){v0[2], v0[3]}), c = gelu_pk((f32x2){v1[0], v1[1]}), d = gelu_pk((f32x2){v1[2], v1[3]});
                        v0 = (f32x4){a.x, a.y, b.x, b.y}; v1 = (f32x4){c.x, c.y, d.x, d.y}; }
                    v0 = v0 * sc; v1 = v1 * sc; u32x4 w; w.x = cvt_pk_bf16(v0[0], v0[1]); w.y = cvt_pk_bf16(v0[2], v0[3]); w.z = cvt_pk_bf16(v1[0], v1[1]); w.w = cvt_pk_bf16(v1[2], v1[3]);
                    *(u32x4*)(rowp + bj * HALF) = w; } }
    }
};

template <class Epi, class Sched, bool ALIGN_EPI = false, bool SP2 = false, bool GATHER = false, bool F8 = false>
__device__ __forceinline__ void gemm_phase(PG8_LAS unsigned char* lds, const Gemm g, const Sched& S, const Epi& E) {
    const int tid = tid_fresh(); const int wid = __builtin_amdgcn_readfirstlane(tid >> 6), lane = tid & 63, wr = wid >> 2, wc = wid & 3, fr = lane & 15, fq = lane >> 4;
    typedef int pg8_i32x8 __attribute__((ext_vector_type(8))); typedef int pg8_i32x4 __attribute__((ext_vector_type(4)));
    const int K = g.K, nt = K / BK;
    unsigned voffA[2], voffB[2];
#pragma unroll
    for (int i = 0; i < 2; ++i) { int R, C; stage_rc(tid * 16 + i * 8192, R, C); const int Rb = Epi::PERM ? ((R & ~31) + perm32(R & 31)) : R;
        voffA[i] = (unsigned)(R * K + C) * 2u; voffB[i] = (unsigned)(Rb * K + C) * 2u; }
    unsigned gC[2][2] = {{0u, 0u}, {0u, 0u}}, gN[2][2] = {{0u, 0u}, {0u, 0u}};
    const size_t kstep = (size_t)(BK * 2);
    const size_t hstep = (size_t)HALF * K * 2;
    const size_t tstep = 2 * hstep;
    const unsigned ldsw = (unsigned)wid * 1024u;
    const int aoff = lds_byte(wr * 64 + fr, fq * 8), boff = lds_byte(wc * 32 + fr, fq * 8);
#define PG8_SA(b, h) (((b) * 2 + (h)) * HTB)
#define PG8_SB(b, h) ((4 + (b) * 2 + (h)) * HTB)
#define PG8_STAGE(bufoff, gbase, voff) do { _Pragma("unroll") for (int _i = 0; _i < 2; ++_i) \
        __builtin_amdgcn_global_load_lds((const unsigned*)((const char*)(gbase) + (voff)[_i]), (PG8_LAS unsigned*)(lds + (bufoff) + ldsw + _i * 8192), 16, 0, 0); } while (0)
#define PG8_GOFF(dst, u) do { if constexpr (GATHER) { _Pragma("unroll") for (int _i = 0; _i < 2; ++_i) _Pragma("unroll") for (int _h = 0; _h < 2; ++_h) { int _R, _C; stage_rc(tid * 16 + _i * 8192, _R, _C); dst[_h][_i] = S.a_off(u, _h * HALF + _R) + (unsigned)(_C * 2); asm volatile("" : "+v"(dst[_h][_i]) :: "memory"); } } } while (0)
#define PG8_STAGE_A(bufoff, kofs, half, nx) do { if constexpr (GATHER) { const char* _b = (const char*)g.A + (kofs); _Pragma("unroll") for (int _i = 0; _i < 2; ++_i) { const unsigned _o = (nx) ? gN[half][_i] : gC[half][_i]; \
            __builtin_amdgcn_global_load_lds((const unsigned*)(_b + _o), (PG8_LAS unsigned*)(lds + (bufoff) + ldsw + _i * 8192), 16, 0, 0); } } \
        else { const char* _b = ((nx) ? nA : cA) + (kofs) + (half) * hstep; PG8_STAGE(bufoff, _b, voffA); } } while (0)
#define PG8_LD16(off) (*(const PG8_LAS pg8_i32x4*)(lds + (off)))
#define PG8_LDA(dst, b, h) do { if constexpr (F8) { _Pragma("unroll") for (int m = 0; m < 4; ++m) dst##8[m] = __builtin_shufflevector(PG8_LD16(PG8_SA(b, h) + aoff + m * 2048), PG8_LD16(PG8_SA(b, h) + aoff + m * 2048 + 1024), 0, 1, 2, 3, 4, 5, 6, 7); } \
    else { _Pragma("unroll") for (int m = 0; m < 4; ++m) _Pragma("unroll") for (int k = 0; k < 2; ++k) dst[m][k] = *(const PG8_LAS bf16x8*)(lds + PG8_SA(b, h) + aoff + m * 2048 + k * 1024); } } while (0)
#define PG8_LDB(dst, b, h) do { if constexpr (F8) { _Pragma("unroll") for (int n = 0; n < 2; ++n) dst##8[n] = __builtin_shufflevector(PG8_LD16(PG8_SB(b, h) + boff + n * 2048), PG8_LD16(PG8_SB(b, h) + boff + n * 2048 + 1024), 0, 1, 2, 3, 4, 5, 6, 7); } \
    else { _Pragma("unroll") for (int n = 0; n < 2; ++n) _Pragma("unroll") for (int k = 0; k < 2; ++k) dst[n][k] = *(const PG8_LAS bf16x8*)(lds + PG8_SB(b, h) + boff + n * 2048 + k * 1024); } } while (0)
#define PG8_MMA(ai, bj, At, Bt) do { __builtin_amdgcn_s_setprio(1); if constexpr (F8) { _Pragma("unroll") for (int m = 0; m < 4; ++m) _Pragma("unroll") for (int n = 0; n < 2; ++n) \
        acc[ai][bj][m][n] = __builtin_amdgcn_mfma_scale_f32_16x16x128_f8f6f4(Bt##8[n], At##8[m], acc[ai][bj][m][n], 0, 0, 0, 0x7f7f7f7f, 0, 0x7f7f7f7f); \
        _Pragma("unroll") for (int m = 0; m < 4; ++m) _Pragma("unroll") for (int n = 0; n < 2; ++n) asm volatile("" : "+v"(acc[ai][bj][m][n]));   } \
    else { _Pragma("unroll") for (int m = 0; m < 4; ++m) _Pragma("unroll") for (int n = 0; n < 2; ++n) _Pragma("unroll") for (int k = 0; k < 2; ++k) \
        acc[ai][bj][m][n] = __builtin_amdgcn_mfma_f32_16x16x32_bf16(Bt[n][k], At[m][k], acc[ai][bj][m][n], 0, 0, 0); } __builtin_amdgcn_s_setprio(0); } while (0)
#define PG8_WAIT_V(n) asm volatile("s_waitcnt vmcnt(" #n ")" ::: "memory")
#define PG8_WAIT_L(n) asm volatile("s_waitcnt lgkmcnt(" #n ")" ::: "memory")
#define PG8_BAR __builtin_amdgcn_s_barrier()
#define PG8_SCHED __builtin_amdgcn_sched_barrier(0)
    Unit cur, nxt; int ui = 0;
    if (!S.next(0, cur)) return;
    f32x4 acc[2][2][4][2];
#pragma unroll
    for (int a = 0; a < 2; ++a)
#pragma unroll
        for (int b = 0; b < 2; ++b)
#pragma unroll
            for (int m = 0; m < 4; ++m)
#pragma unroll
                for (int n = 0; n < 2; ++n) acc[a][b][m][n] = (f32x4){0.f, 0.f, 0.f, 0.f};
    bf16x8 At[4][2], B0[2][2], B1[2][2]; pg8_i32x8 At8[4], B08[2], B18[2];
    const char* cA = (const char*)g.A + (size_t)cur.pm * tstep; const char* cB = (const char*)g.Bt + (size_t)cur.pn * tstep;
    S.a_ready(cur);
    PG8_GOFF(gC, cur);
    if constexpr (SP2) {
        const char* nA = cA;
        PG8_STAGE(PG8_SB(0, 0), cB, voffB); PG8_STAGE(PG8_SB(0, 1), cB + hstep, voffB); PG8_STAGE_A(PG8_SA(0, 0), 0, 0, false); PG8_STAGE_A(PG8_SA(0, 1), 0, 1, false);
        if (wr == 1) PG8_BAR;
        PG8_WAIT_V(2); PG8_BAR;
        PG8_STAGE(PG8_SB(1, 0), cB + kstep, voffB); PG8_STAGE_A(PG8_SA(1, 0), kstep, 0, false); PG8_STAGE(PG8_SB(1, 1), cB + hstep + kstep, voffB);
        PG8_WAIT_V(6); PG8_BAR;
    } else {
        const char* nA = cA;
        PG8_STAGE(PG8_SB(0, 0), cB, voffB); PG8_STAGE_A(PG8_SA(0, 0), 0, 0, false); PG8_STAGE(PG8_SB(0, 1), cB + hstep, voffB); PG8_STAGE_A(PG8_SA(0, 1), 0, 1, false);
        if (wr == 1) PG8_BAR;
        PG8_WAIT_V(4); PG8_BAR;
        PG8_STAGE(PG8_SB(1, 0), cB + kstep, voffB); PG8_STAGE_A(PG8_SA(1, 0), kstep, 0, false); PG8_STAGE(PG8_SB(1, 1), cB + hstep + kstep, voffB);
        PG8_WAIT_V(6); PG8_BAR;
    }
    for (;;) {
        const bool has_next = S.next(ui + 1, nxt);
        const char* nA = has_next ? (const char*)g.A + (size_t)nxt.pm * tstep : cA; const char* nB = has_next ? (const char*)g.Bt + (size_t)nxt.pn * tstep : cB;
        if constexpr (GATHER) { if (has_next) PG8_GOFF(gN, nxt); else { _Pragma("unroll") for (int _h = 0; _h < 2; ++_h) _Pragma("unroll") for (int _i = 0; _i < 2; ++_i) gN[_h][_i] = gC[_h][_i]; } }
        for (int t = 0; t < nt; t += 2) {
            const bool last = (t == nt - 2);
            const char* a1 = cA + (size_t)(t + 1) * kstep;
            const char* a2 = last ? nA : cA + (size_t)(t + 2) * kstep; const char* b2 = last ? nB : cB + (size_t)(t + 2) * kstep;
            const char* a3 = a2 + kstep; const char* b3 = b2 + kstep;
            const size_t k1 = (size_t)(t + 1) * kstep, k2 = last ? (size_t)0 : (size_t)(t + 2) * kstep, k3 = k2 + kstep;
            if (last && has_next) S.a_ready(nxt);
            if constexpr (SP2) {
            PG8_LDB(B0, 0, 0); PG8_LDB(B1, 0, 1); PG8_SCHED; PG8_LDA(At, 0, 0); PG8_STAGE_A(PG8_SA(1, 1), k1, 1, false);
            PG8_WAIT_V(8); PG8_WAIT_L(0); PG8_BAR;
            if constexpr (Epi::LDS_BIAS) { if (t == 0) E.stage_bias(cur, lds, wid, lane); }
            PG8_MMA(0, 0, At, B0); PG8_MMA(0, 1, At, B1); PG8_BAR; PG8_SCHED;
            PG8_LDA(At, 0, 1); PG8_STAGE(PG8_SB(0, 0), b2, voffB); PG8_STAGE(PG8_SB(0, 1), b2 + hstep, voffB); PG8_STAGE_A(PG8_SA(0, 0), k2, 0, last);
            PG8_WAIT_V(8); PG8_WAIT_L(0); PG8_BAR; PG8_MMA(1, 0, At, B0); PG8_MMA(1, 1, At, B1); PG8_BAR; PG8_SCHED;
            PG8_LDB(B0, 1, 0); PG8_LDB(B1, 1, 1); PG8_SCHED; PG8_LDA(At, 1, 0); PG8_STAGE_A(PG8_SA(0, 1), k2, 1, last);
            PG8_WAIT_V(8); PG8_WAIT_L(0); PG8_BAR; PG8_MMA(0, 0, At, B0); PG8_MMA(0, 1, At, B1); PG8_BAR; PG8_SCHED;
            PG8_LDA(At, 1, 1); PG8_STAGE(PG8_SB(1, 0), b3, voffB); PG8_STAGE(PG8_SB(1, 1), b3 + hstep, voffB); PG8_STAGE_A(PG8_SA(1, 0), k3, 0, last);
            PG8_WAIT_V(8); PG8_WAIT_L(0); PG8_BAR; PG8_MMA(1, 0, At, B0); PG8_MMA(1, 1, At, B1); PG8_BAR; PG8_SCHED;
            } else {
            PG8_LDB(B0, 0, 0); PG8_SCHED; PG8_LDA(At, 0, 0); PG8_STAGE_A(PG8_SA(1, 1), k1, 1, false);
            PG8_WAIT_L(8); PG8_BAR; PG8_WAIT_L(0); PG8_MMA(0, 0, At, B0); PG8_BAR; PG8_SCHED;
            PG8_LDB(B1, 0, 1); PG8_STAGE(PG8_SB(0, 0), b2, voffB);
            PG8_BAR; PG8_WAIT_L(0); PG8_MMA(0, 1, At, B1); PG8_BAR;
            PG8_LDA(At, 0, 1); PG8_STAGE_A(PG8_SA(0, 0), k2, 0, last);
            PG8_BAR; PG8_WAIT_L(0); PG8_MMA(1, 0, At, B0); PG8_BAR; PG8_SCHED;
            PG8_STAGE(PG8_SB(0, 1), b2 + hstep, voffB);
            PG8_WAIT_V(6); PG8_BAR; PG8_MMA(1, 1, At, B1); PG8_BAR;
            PG8_LDB(B0, 1, 0); PG8_SCHED; PG8_LDA(At, 1, 0); PG8_STAGE_A(PG8_SA(0, 1), k2, 1, last);
            PG8_WAIT_L(8); PG8_BAR; PG8_WAIT_L(0); PG8_MMA(0, 0, At, B0); PG8_BAR; PG8_SCHED;
            PG8_LDB(B1, 1, 1); PG8_STAGE(PG8_SB(1, 0), b3, voffB);
            PG8_BAR; PG8_WAIT_L(0); PG8_MMA(0, 1, At, B1); PG8_BAR;
            PG8_LDA(At, 1, 1); PG8_STAGE_A(PG8_SA(1, 0), k3, 0, last);
            PG8_BAR; PG8_WAIT_L(0); PG8_MMA(1, 0, At, B0); PG8_BAR; PG8_SCHED;
            PG8_STAGE(PG8_SB(1, 1), b3 + hstep, voffB);
            PG8_WAIT_V(6); PG8_BAR; PG8_MMA(1, 1, At, B1); PG8_BAR;
            }
        }
        if constexpr (ALIGN_EPI) { if (wr == 0) PG8_BAR; }
        if constexpr (!Epi::AFTER_DRAIN) { E(acc, cur, wr, wc, fr, fq); S.done(cur); }
        if (!has_next) break;
#pragma unroll
        for (int a = 0; a < 2; ++a)
#pragma unroll
            for (int b = 0; b < 2; ++b)
#pragma unroll
                for (int m = 0; m < 4; ++m)
#pragma unroll
                    for (int n = 0; n < 2; ++n) acc[a][b][m][n] = (f32x4){0.f, 0.f, 0.f, 0.f};
        cur = nxt; cA = nA; cB = nB; ++ui;
        if constexpr (GATHER) { _Pragma("unroll") for (int _h = 0; _h < 2; ++_h) _Pragma("unroll") for (int _i = 0; _i < 2; ++_i) gC[_h][_i] = gN[_h][_i]; }
        if constexpr (ALIGN_EPI) { if (wr == 1) PG8_BAR; }
    }
    PG8_WAIT_V(0);
    if constexpr (!ALIGN_EPI) { if (wr == 0) PG8_BAR; }
    PG8_BAR;
    if constexpr (Epi::AFTER_DRAIN) { E.fused(acc, cur, wr, wc, fr, fq, lds, wid, lane); S.done(cur); }
#undef PG8_SA
#undef PG8_SB
#undef PG8_STAGE
#undef PG8_GOFF
#undef PG8_STAGE_A
#undef PG8_LDA
#undef PG8_LDB
#undef PG8_MMA
#undef PG8_LD16
#undef PG8_WAIT_V
#undef PG8_WAIT_L
#undef PG8_BAR
#undef PG8_SCHED
}
}

#ifndef PG8_SP2
#define PG8_SP2 true
#endif
#ifndef PG8_ALIGN
#define PG8_ALIGN true
#endif
#define GAS __attribute__((address_space(1)))
#define LAS __attribute__((address_space(3)))
typedef unsigned short bf16;
typedef unsigned v4u __attribute__((ext_vector_type(4)));
typedef unsigned v2u __attribute__((ext_vector_type(2)));
typedef float f32x4 __attribute__((ext_vector_type(4)));
typedef short bf16x8 __attribute__((ext_vector_type(8)));
constexpr int D = 1024, NB = 4, SEQ = 4096, CTX = 256, TPB = SEQ + CTX  , T = NB * TPB  , PPB = TPB / 256  ;
constexpr int EVEN_IN = 4128, ODD_IN = 6144, NE = 32, TOPK = 4, DFF = 1024;
constexpr int LDP0 = 4352, LDP1 = 6144;
constexpr int MOE_ROWS = (T * TOPK / 256 + NE) * 256;
constexpr float EPS = 1e-6f;
constexpr int NWAVES = 8, NTHR = 512;
constexpr int LDS_BYTES = 131072 + 4096 + 2048;
constexpr int LDS_BIAS_OFF = 131072 + 4096;
constexpr int C_GQ = 0, C_GK = 512, C_GV = 1024, C_Z = 1536, C_MQ = 2048, C_MK = 2560, C_MV = 3072, C_MO = 3584, C_AG = 4096, C_BG = 4104, C_IG = 4112, C_FG = 4120;
constexpr int C_RQ = 0, C_RK = 1024, C_RV = 2048, C_RG = 4096;

__device__ __forceinline__ int bid_fresh() { int t = blockIdx.x; asm volatile("" : "+s"(t)); return t; }
__device__ __forceinline__ float sigmoidf_(float x) { return __builtin_amdgcn_rcpf(1.f + __expf(-x)); }
__device__ __forceinline__ float siluf_(float x) { return x * sigmoidf_(x); }
__device__ __forceinline__ float softplusf_(float x) { return fmaxf(x, 0.f) + log1pf(__expf(-fabsf(x))); }
__device__ __forceinline__ float bflo(unsigned u) { return __uint_as_float(u << 16); }
__device__ __forceinline__ float bfhi(unsigned u) { return __uint_as_float(u & 0xffff0000u); }
__device__ __forceinline__ float bf2f(bf16 v) { return __uint_as_float(((unsigned)v) << 16); }
typedef __bf16 hw_bf2 __attribute__((ext_vector_type(2)));
typedef float hw_f2 __attribute__((ext_vector_type(2)));
__device__ __forceinline__ unsigned pk2(float lo, float hi) { const hw_f2 v = {lo, hi}; return __builtin_bit_cast(unsigned, __builtin_convertvector(v, hw_bf2)); }
__device__ __forceinline__ unsigned f2bf(float f) { return pk2(f, 0.f) & 0xffffu; }
__device__ __forceinline__ unsigned pk4_f8(float a, float b, float c2, float d) { int v = __builtin_amdgcn_cvt_pk_fp8_f32(a, b, 0, false); v = __builtin_amdgcn_cvt_pk_fp8_f32(c2, d, v, true); return (unsigned)v; }
__device__ __forceinline__ float shflx(float v, int off, int lane) { return __builtin_bit_cast(float, __builtin_amdgcn_ds_bpermute((lane ^ off) << 2, __builtin_bit_cast(int, v))); }
__device__ __forceinline__ int shflxi(int v, int off, int lane) { return __builtin_amdgcn_ds_bpermute((lane ^ off) << 2, v); }
__device__ __forceinline__ float wave_sum(float v) {
    int ln = (int)__builtin_amdgcn_mbcnt_hi(~0u, __builtin_amdgcn_mbcnt_lo(~0u, 0u)); asm volatile("" : "+v"(ln));
#pragma unroll
    for (int o = 1; o < 64; o <<= 1) v += shflx(v, o, ln);
    return v;
}
__device__ __forceinline__ float block_sum256(float v, float* red) {
    v = wave_sum(v);
    __syncthreads();
    if ((threadIdx.x & 63) == 0) red[threadIdx.x >> 6] = v;
    __syncthreads();
    return red[0] + red[1] + red[2] + red[3];
}
__device__ __forceinline__ int seq_pos(int n, int d) { return d == 0 ? n : (n < CTX ? CTX - 1 - n : TPB + CTX - 1 - n); }

struct Params {
    const float *x, *c, *ctx, *c_ctx, *mod_w, *mod_b, *norm1_g, *norm2_g, *ev_w_in, *ev_conv_w, *gdn_a_log, *gdn_dt_bias, *gdn_norm_g, *ml_i_bias, *ml_f_bias, *ml_norm_g, *ev_w_out,
        *od_w_in, *ret_norm_g, *od_w_out, *router_w, *router_b, *moe_w_gu, *moe_b_gu, *moe_w_dn, *moe_b_dn, *final_g;
    float* out;
    unsigned* ctl;
    float* mod;
    float* xres;
    float* rope;
    bf16* od;
    bf16* hb;
    bf16* P;
    bf16* merged;
    bf16 *wt_in0, *wt_out0, *wt_in1, *wt_out1, *wt_gu, *wt_dn;
    bf16 *hs, *act, *yb;
    int *asg_e, *asg_pos, *slot_tok; float* asg_w;
    unsigned char* h8;
    bf16 *rwh, *rwl;
    float* scr0; float* scr1; float* scr2;
};

#define LDS_BARRIER() do { asm volatile("s_waitcnt lgkmcnt(0)" ::: "memory"); __builtin_amdgcn_s_barrier(); asm volatile("" ::: "memory"); } while (0)
typedef const Params __attribute__((address_space(4)))* KP;
#define CP const Params __attribute__((address_space(4)))&
__device__ __forceinline__ KP kp_fresh() { KP q = (KP)__builtin_amdgcn_kernarg_segment_ptr(); asm volatile("" : "+s"(q)); return q; }
#define XB_TMO      128
#define XB_XCNT(j)  (256  + 64 * (j))
#define XB_XSUB(j)  (1280 + 64 * (j))
#define XB_XGEN(j)  (2304 + 64 * (j))
#define XB_TOP      3328
#define XB_TOPGEN   3392
#define XCD_BAR_WORDS 3456
#define XB_SPIN_CAP (1u << 22)

__device__ __forceinline__ unsigned xb_ld(unsigned* p)              { return __hip_atomic_load(p, __ATOMIC_RELAXED, __HIP_MEMORY_SCOPE_AGENT); }
__device__ __forceinline__ unsigned xb_add(unsigned* p, unsigned v) { return __hip_atomic_fetch_add(p, v, __ATOMIC_RELAXED, __HIP_MEMORY_SCOPE_AGENT); }
__device__ __forceinline__ unsigned xb_xcc_id() { return (unsigned)__builtin_amdgcn_s_getreg((3 << 11) | 20) & 0xFu; }
#define XB_SPIN(cond, bar) do { unsigned _sp = 0; while (cond) { __builtin_amdgcn_s_sleep(1); \
    if ((++_sp & 255u) == 0u) { if (xb_ld(&(bar)[XB_TMO])) break; if (_sp > XB_SPIN_CAP) { atomicAdd(&(bar)[XB_TMO], 1u); break; } } } } while (0)

struct XcdBarrier {
    unsigned* bar; unsigned x;
    volatile LAS unsigned* st;
};

__device__ __forceinline__ XcdBarrier xcd_barrier_post(unsigned* bar, volatile LAS unsigned* st) {
    XcdBarrier b; b.bar = bar; b.x = xb_xcc_id(); b.st = st;
    if (tid_fresh() == 0) (void)xb_add(&bar[XB_XCNT(b.x)], 1u);
    return b;
}
__device__ __forceinline__ void xcd_barrier_complete(unsigned* bar, unsigned x, unsigned& nloc, unsigned& nx) {
    const unsigned G = gridDim.x * gridDim.y * gridDim.z;
    unsigned sum, cnt, mine, sp = 0u;
    for (;;) {
        sum = 0u; cnt = 0u; mine = 0u;
#pragma unroll
        for (unsigned j = 0; j < 16; ++j) { const unsigned c = xb_ld(&bar[XB_XCNT(j)]); sum += c; cnt += (c > 0u) ? 1u : 0u; mine = (j == x) ? c : mine; }
        if (sum == G) break;
        __builtin_amdgcn_s_sleep(1);
        if ((++sp & 255u) == 0u) { if (xb_ld(&bar[XB_TMO])) break; if (sp > XB_SPIN_CAP) { atomicAdd(&bar[XB_TMO], 1u); break; } }
    }
    nloc = mine > 0u ? mine : 1u; nx = cnt > 0u ? cnt : 1u;
}

__device__ __forceinline__ void xcd_barrier(const XcdBarrier& b) {
    asm volatile("s_waitcnt vmcnt(0)" ::: "memory");
    __syncthreads();
    if (tid_fresh() == 0) {
        unsigned* bar = b.bar;
        __builtin_amdgcn_s_waitcnt(0);
        unsigned nloc = b.st[0], nx = b.st[1];
        if (nloc == 0u) { xcd_barrier_complete(bar, b.x, nloc, nx); b.st[0] = nloc; b.st[1] = nx; }
        const unsigned old = xb_add(&bar[XB_XSUB(b.x)], 1u);
        const unsigned gen = old / nloc;
        if (old + 1u == (gen + 1u) * nloc) {
            __builtin_amdgcn_fence(__ATOMIC_RELEASE, "agent");
            asm volatile("s_waitcnt vmcnt(0)" ::: "memory");
            const unsigned og = xb_add(&bar[XB_TOP], 1u);
            const unsigned tg = og / nx;
            if (og + 1u == (tg + 1u) * nx) xb_add(&bar[XB_TOPGEN], 1u);
            else XB_SPIN(xb_ld(&bar[XB_TOPGEN]) == tg, bar);
            __builtin_amdgcn_fence(__ATOMIC_ACQUIRE, "agent");
            xb_add(&bar[XB_XGEN(b.x)], 1u);
            asm volatile("s_waitcnt vmcnt(0)" ::: "memory");
        } else {
            XB_SPIN(xb_ld(&bar[XB_XGEN(b.x)]) == gen, bar);
            __builtin_amdgcn_fence(__ATOMIC_ACQUIRE, "agent");
            asm volatile("s_waitcnt vmcnt(0)" ::: "memory");
        }
    }
    __syncthreads();
}

struct MapId { __device__ __forceinline__ int operator()(int n) const { return n; } };
struct MapIn0 { __device__ __forceinline__ int operator()(int n) const { return n < 2048 ? n : (n < 2064 ? 4096 + (n - 2048) : (n < 4112 ? n - 16 : n)); } };
struct MapGu { __device__ __forceinline__ int operator()(int n) const { const int j = n >> 1, s = n & 1; return 256 * (j >> 7) + 128 * s + (j & 127); } };

template <class Map>
__device__ __forceinline__ void transpose_item(const float* W, int K, int N, bf16* WT, LAS float* scr, int item, int lane, Map map) {
    const int nblk = N / 32, kb = item / nblk, nb = item % nblk, k0 = 64 * kb, n0 = 32 * nb;
    float tv[32];
#pragma unroll
    for (int i = 0; i < 32; ++i) tv[i] = __builtin_nontemporal_load(W + (size_t)(k0 + 2 * i + (lane >> 5)) * N + n0 + (lane & 31));
#pragma unroll
    for (int i = 0; i < 32; ++i) scr[(2 * i + (lane >> 5)) * 33 + (lane & 31)] = tv[i];
    asm volatile("s_waitcnt lgkmcnt(0)" ::: "memory");
    const int c = lane & 7;
#pragma unroll
    for (int j = 0; j < 4; ++j) { const int n = (lane >> 3) + 8 * j; const LAS float* s = scr + (8 * c) * 33 + n;
        v4u o; o.x = pk2(s[0 * 33], s[1 * 33]); o.y = pk2(s[2 * 33], s[3 * 33]); o.z = pk2(s[4 * 33], s[5 * 33]); o.w = pk2(s[6 * 33], s[7 * 33]);
        __builtin_nontemporal_store(o, (v4u*)(WT + (size_t)map(n0 + n) * K + k0 + 8 * c)); }
    asm volatile("s_waitcnt lgkmcnt(0)" ::: "memory");
}


constexpr float WSCALE = 32.f, WSCALE_INV = 1.f / 32.f;
template <class Map>
__device__ __forceinline__ void transpose_item_f8(const float* W, int K, int N, unsigned char* WT, LAS float* scr, int item, int lane, Map map) {
    const int nblk = N / 32, kb = item / nblk, nb = item % nblk, k0 = 64 * kb, n0 = 32 * nb;
    float tv[32];
#pragma unroll
    for (int i = 0; i < 32; ++i) tv[i] = __builtin_nontemporal_load(W + (size_t)(k0 + 2 * i + (lane >> 5)) * N + n0 + (lane & 31));
#pragma unroll
    for (int i = 0; i < 32; ++i) scr[(2 * i + (lane >> 5)) * 33 + (lane & 31)] = tv[i] * WSCALE;
    asm volatile("s_waitcnt lgkmcnt(0)" ::: "memory");
    const int c = lane & 7;
#pragma unroll
    for (int j = 0; j < 4; ++j) { const int n = (lane >> 3) + 8 * j; const LAS float* s = scr + (8 * c) * 33 + n;
        v2u o; o.x = pk4_f8(s[0 * 33], s[1 * 33], s[2 * 33], s[3 * 33]); o.y = pk4_f8(s[4 * 33], s[5 * 33], s[6 * 33], s[7 * 33]);
        __builtin_nontemporal_store(o, (v2u*)(WT + (size_t)map(n0 + n) * K + k0 + 8 * c)); }
    asm volatile("s_waitcnt lgkmcnt(0)" ::: "memory");
}

template <class Map>
__device__ __forceinline__ void transpose_item64(const float* W, int K, int N, bf16* WT, LAS float* scr, int item, int lane, Map map) {
    const int nblk = N / 64, kb = item / nblk, nb = item % nblk, k0 = 64 * kb, n0 = 64 * nb;
    float tv[64];
#pragma unroll
    for (int i = 0; i < 64; ++i) tv[i] = __builtin_nontemporal_load(W + (size_t)(k0 + i) * N + n0 + lane);
#pragma unroll
    for (int i = 0; i < 64; ++i) scr[i * 64 + (lane ^ i)] = tv[i];
    asm volatile("s_waitcnt lgkmcnt(0)" ::: "memory");
    const int c = lane & 7;
#pragma unroll
    for (int j = 0; j < 8; ++j) { const int n = (lane >> 3) + 8 * j; const LAS float* s = scr + (8 * c) * 64;
#define TS(e) s[(e) * 64 + (n ^ (8 * c + (e)))]
        v4u o; o.x = pk2(TS(0), TS(1)); o.y = pk2(TS(2), TS(3)); o.z = pk2(TS(4), TS(5)); o.w = pk2(TS(6), TS(7));
#undef TS
        __builtin_nontemporal_store(o, (v4u*)(WT + (size_t)map(n0 + n) * K + k0 + 8 * c)); }
    asm volatile("s_waitcnt lgkmcnt(0)" ::: "memory");
}

__device__ __forceinline__ void ph_prologue(CP p, LAS unsigned char* lds) {
    const int tid = tid_fresh(), lane = tid & 63, wave = tid >> 6, G = gridDim.x;
    const int gw = blockIdx.x * NWAVES + wave, NGW = G * NWAVES;
    LAS float* scond = (LAS float*)(lds + 72 * 1024);
    for (int i = tid; i < 5 * D; i += NTHR) { const int r = i >> 10, k = i & 1023; scond[i] = siluf_(r < 4 ? p.c[r * D + k] : p.c_ctx[k]); }
    __syncthreads();
    LAS float* red = scond + 5 * D;
    for (int it = blockIdx.x; it < 2 * 96; it += G) {
        const int l = it / 96, j = (it % 96) * 64 + lane;
        const float* w = p.mod_w + (size_t)l * D * 6 * D + j;
        float a0 = 0.f, a1 = 0.f, a2 = 0.f, a3 = 0.f, a4 = 0.f;
        const int kb = wave * (D / NWAVES);
#pragma unroll 16
        for (int k = kb; k < kb + D / NWAVES; ++k) { const float wv = w[(size_t)k * 6 * D]; a0 += scond[k] * wv; a1 += scond[D + k] * wv; a2 += scond[2 * D + k] * wv; a3 += scond[3 * D + k] * wv; a4 += scond[4 * D + k] * wv; }
        red[(wave * 5 + 0) * 64 + lane] = a0; red[(wave * 5 + 1) * 64 + lane] = a1; red[(wave * 5 + 2) * 64 + lane] = a2; red[(wave * 5 + 3) * 64 + lane] = a3; red[(wave * 5 + 4) * 64 + lane] = a4;
        __syncthreads();
        if (wave < 5) { float s = p.mod_b[l * 6 * D + j];
#pragma unroll
            for (int ww = 0; ww < NWAVES; ++ww) s += red[(ww * 5 + wave) * 64 + lane];
            p.mod[(size_t)l * 5 * 6 * D + (size_t)wave * 6 * D + j] = s; }
        __syncthreads();
    }
    for (int i = blockIdx.x * NTHR + tid; i < 2 * D * NE; i += G * NTHR) { const int l = i / (D * NE), k = (i / NE) % D, e = i % NE; const float wv = p.router_w[i]; const unsigned hi = f2bf(wv); const float rem = wv - __uint_as_float(hi << 16);
        p.rwh[((size_t)l * NE + e) * D + k] = (bf16)hi; p.rwl[((size_t)l * NE + e) * D + k] = (bf16)f2bf(rem); }
    { v4u z = {0u, 0u, 0u, 0u}; v4u* dst = (v4u*)(p.wt_in0 + (size_t)EVEN_IN * D); const int n16 = (LDP0 - EVEN_IN) * D / 8;
      for (int i = blockIdx.x * NTHR + tid; i < n16; i += G * NTHR) dst[i] = z; }
    for (int i = blockIdx.x * NTHR + tid; i < TPB * 64; i += G * NTHR) { const int pos = i >> 6, fi = i & 63; const float ang = (float)pos * powf(10000.f, -(float)fi / 64.f); float sn, cs; sincosf(ang, &sn, &cs); p.rope[2 * i] = cs; p.rope[2 * i + 1] = sn; }
    __syncthreads();
    LAS float* scr = (LAS float*)(lds + wave * 8448);
    constexpr int I_IN0 = 16 * (EVEN_IN / 32), I_OUT0 = 16 * 32, I_IN1 = 16 * (ODD_IN / 32), I_OUT1 = 32 * 32, I_GU1 = 16 * 64, I_DN1 = 16 * 32;
    constexpr int NITEMS = I_IN0 + I_OUT0 + I_IN1 + I_OUT1 + 32 * I_GU1 + 32 * I_DN1;
    for (int it = gw; it < NITEMS; it += NGW) {
        int r = it;
        if (r < I_IN0) { transpose_item(p.ev_w_in, D, EVEN_IN, p.wt_in0, scr, r, lane, MapIn0()); continue; } r -= I_IN0;
        if (r < I_OUT0) { transpose_item(p.ev_w_out, D, D, p.wt_out0, scr, r, lane, MapId()); continue; } r -= I_OUT0;
        if (r < I_IN1) { transpose_item(p.od_w_in, D, ODD_IN, p.wt_in1, scr, r, lane, MapId()); continue; } r -= I_IN1;
        if (r < I_OUT1) { transpose_item(p.od_w_out, 2 * D, D, p.wt_out1, scr, r, lane, MapId()); continue; } r -= I_OUT1;
        if (r < 32 * I_GU1) { const int m = r / I_GU1; transpose_item_f8(p.moe_w_gu + (size_t)m * D * 2 * DFF, D, 2 * DFF, (unsigned char*)p.wt_gu + (size_t)m * 2 * DFF * D, scr, r % I_GU1, lane, MapGu()); continue; } r -= 32 * I_GU1;
        { const int m = r / I_DN1; transpose_item_f8(p.moe_w_dn + (size_t)m * DFF * D, DFF, D, (unsigned char*)p.wt_dn + (size_t)m * D * DFF, scr, r % I_DN1, lane, MapId()); }
    }
}


constexpr int NDEF = 32 * (16 * 64) + 32 * (16 * 32), FILL_CTR = 9000;
constexpr int FILL_BATCH = 16;
__device__ __forceinline__ void ph_fill(CP p, LAS unsigned char* lds, int s0, int e0, int q) {
    if (s0 >= e0) return;
    const int tid = tid_fresh(), lane = tid & 63, wave = tid >> 6;
    LAS float* scr = (LAS float*)(lds + wave * 8448);
    LAS int* slot = (LAS int*)(lds + 131072 + 1536);
    int* ctr = (int*)p.ctl + FILL_CTR + 64 * q;
    int nxt = 0;
    if (tid == 0) nxt = atomicAdd(ctr, FILL_BATCH);
    for (;;) {
        __syncthreads();
        if (tid == 0) *slot = nxt;
        __syncthreads();
        const int i0 = s0 + *slot;
        if (i0 >= e0) break;
        if (tid == 0) nxt = atomicAdd(ctr, FILL_BATCH);
        for (int k = 0; k < FILL_BATCH / 8; ++k) { const int idx = i0 + wave * (FILL_BATCH / 8) + k; if (idx >= e0) break;
            if (idx < 32 * 1024) { const int m = 32 + (idx >> 10); transpose_item_f8(p.moe_w_gu + (size_t)m * D * 2 * DFF, D, 2 * DFF, (unsigned char*)p.wt_gu + (size_t)m * 2 * DFF * D, scr, idx & 1023, lane, MapGu()); }
            else { const int j = idx - 32 * 1024, m = 32 + (j >> 9); transpose_item_f8(p.moe_w_dn + (size_t)m * DFF * D, DFF, D, (unsigned char*)p.wt_dn + (size_t)m * D * DFF, scr, j & 511, lane, MapId()); } }
    }
}
#ifndef FQ_IN0
#define FQ_IN0 5000
#define FQ_LOCAL 12000
#define FQ_SEQ 23000
#define FQ_OUT0 37000
#define FQ_GU0 37000
#define FQ_DN0 42000
#define FQ_IN1 49152
#endif
#define FILL_IN0 0, FQ_IN0, 0
#define FILL_LOCAL FQ_IN0, FQ_LOCAL, 1
#define FILL_SEQ FQ_LOCAL, FQ_SEQ, 2
#define FILL_OUT0 FQ_SEQ, FQ_OUT0, 3
#define FILL_GU0 FQ_OUT0, FQ_GU0, 4
#define FILL_DN0 FQ_GU0, FQ_DN0, 5
#define FILL_IN1 FQ_DN0, FQ_IN1, 6
#define FILL_CATCH FQ_IN1, NDEF, 7

__device__ __forceinline__ const float* src_row_l0(CP p, int t) {
    const int b = t / TPB, pp = t % TPB;
    return pp < CTX ? p.ctx + ((size_t)b * CTX + pp) * D : p.x + ((size_t)b * SEQ + (pp - CTX)) * D;
}
__device__ __forceinline__ void ph_norm(CP p, int layer, int which  ) {
    const int tid_ = tid_fresh(), lane = tid_ & 63, gw = blockIdx.x * NWAVES + (tid_ >> 6), NGW = gridDim.x * NWAVES;
    const float* g = (which ? p.norm2_g : p.norm1_g) + layer * D;
    const float* modl = p.mod + (size_t)layer * 5 * 6 * D + (which ? 3 * D : 0);
    for (int t = gw; t < T; t += NGW) {
        const int b = t / TPB, pp = t % TPB, r = pp < CTX ? 4 : b;
        const float* xr = (layer == 0 && which == 0) ? src_row_l0(p, t) : p.xres + (size_t)t * D;
        const f32x4* x4 = (const f32x4*)xr + lane; const f32x4* g4 = (const f32x4*)g + lane; const f32x4* sh4 = (const f32x4*)(modl + (size_t)r * 6 * D) + lane; const f32x4* sc4 = sh4 + D / 4;
        f32x4 v[4]; float s = 0.f;
#pragma unroll
        for (int j = 0; j < 4; ++j) { v[j] = x4[64 * j]; s += (v[j].x * v[j].x + v[j].y * v[j].y) + (v[j].z * v[j].z + v[j].w * v[j].w); }
        const float rs = rsqrtf(wave_sum(s) * (1.f / D) + EPS);
#pragma unroll
        for (int j = 0; j < 4; ++j) { const f32x4 gg = g4[64 * j], sh = sh4[64 * j], sc = sc4[64 * j];
            f32x4 h; h.x = (v[j].x * rs * gg.x) * (1.f + sc.x) + sh.x; h.y = (v[j].y * rs * gg.y) * (1.f + sc.y) + sh.y; h.z = (v[j].z * rs * gg.z) * (1.f + sc.z) + sh.z; h.w = (v[j].w * rs * gg.w) * (1.f + sc.w) + sh.w;
            v2u o; o.x = pk2(h.x, h.y); o.y = pk2(h.z, h.w);
            *((v2u*)(p.hb + (size_t)t * D) + lane + 64 * j) = o;
            }
    }
}

struct LatOrder {
    int G, c;
    __device__ __forceinline__ bool next(int i, pg8::Unit& u) const { const int L = i * G + c; if (L >= 64 * 4) return false; const int q = L >> 2; u.pm = (q >> 4) * PPB + 1 + (q & 15); u.pn = L & 3; return true; }
    __device__ __forceinline__ void a_ready(const pg8::Unit&) const {}
    __device__ __forceinline__ void done(const pg8::Unit&) const {}
};
struct MoeOrder {
    const int* base; int ntn, G, c;
    __device__ __forceinline__ bool next(int i, pg8::Unit& u) const {
        const int nb = __builtin_amdgcn_readfirstlane(base[NE]) >> 8, per = (nb + 7) >> 3, x = c & 7, ul = i * (G >> 3) + (c >> 3);
        const int rbl = ul / ntn, pn = ul % ntn, rb = x * per + rbl; if (rbl >= per || rb >= nb) return false;
        const int r0 = rb << 8; int e = 0;
        for (int k = 1; k < NE; ++k) e = (r0 >= __builtin_amdgcn_readfirstlane(base[k])) ? k : e;
        u.pm = __builtin_amdgcn_readfirstlane(rb); u.pn = __builtin_amdgcn_readfirstlane(e * ntn + pn); return true;
    }
    __device__ __forceinline__ void a_ready(const pg8::Unit&) const {}
    __device__ __forceinline__ void done(const pg8::Unit&) const {}
};
struct MoeGatherOrder {
    const int* base  ; const int* slot_tok; int ntn, G, c;
    __device__ __forceinline__ bool next(int i, pg8::Unit& u) const {
        const int nb = __builtin_amdgcn_readfirstlane(base[NE]) >> 8, per = (nb + 7) >> 3, x = c & 7, ul = i * (G >> 3) + (c >> 3);
        const int rbl = ul / ntn, pn = ul % ntn, rb = x * per + rbl; if (rbl >= per || rb >= nb) return false;
        const int r0 = rb << 8; int e = 0;
        for (int k = 1; k < NE; ++k) e = (r0 >= __builtin_amdgcn_readfirstlane(base[k])) ? k : e;
        u.pm = __builtin_amdgcn_readfirstlane(rb); u.pn = __builtin_amdgcn_readfirstlane(e * ntn + pn); return true;
    }
    __device__ __forceinline__ unsigned a_off(const pg8::Unit& u, int r) const {
        const int e = u.pn / ntn, lb0 = (u.pm << 8) - __builtin_amdgcn_readfirstlane(base[e]), cnt_e = __builtin_amdgcn_readfirstlane(base[40 + e]), local = lb0 + r;
        const int tok = local < cnt_e ? slot_tok[e * T + local] : 0;
        return (unsigned)tok * (unsigned)D;
    }
    __device__ __forceinline__ void a_ready(const pg8::Unit&) const {}
    __device__ __forceinline__ void done(const pg8::Unit&) const {}
};
struct MoeCapOrder {
    const int* base; int ntn, G, c;
    __device__ __forceinline__ bool next(int i, pg8::Unit& u) const {
        const int nb = __builtin_amdgcn_readfirstlane(base[NE]) >> 8, per = (nb + 7) >> 3, x = c & 7, ul = i * (G >> 3) + (c >> 3);
        const int rbl = ul / ntn, pn = ul % ntn, rb = x * per + rbl; if (rbl >= per || rb >= nb) return false;
        const int e = __builtin_amdgcn_readfirstlane((int)((const unsigned char*)base)[320 + rb]);
        const int lb = rb - (__builtin_amdgcn_readfirstlane(base[e]) >> 8);
        u.pm = __builtin_amdgcn_readfirstlane(e * (T / 256) + lb); u.pn = __builtin_amdgcn_readfirstlane(e * ntn + pn); return true;
    }
    __device__ __forceinline__ void a_ready(const pg8::Unit&) const {}
    __device__ __forceinline__ void done(const pg8::Unit&) const {}
};
struct EpiResid {
    static constexpr bool PERM = false, AFTER_DRAIN = false, LDS_BIAS = false;
    const float* x; const float* ctx; bf16* xres; const float* gate  ; int layer0;
    __device__ __forceinline__ void operator()(const pg8::f32x4 (&acc)[2][2][4][2], const pg8::Unit& u, int wr, int wc, int fr, int fq) const {
        const int b = u.pm / PPB, j = u.pm % PPB, r = j == 0 ? 4 : b;
        const int col0 = u.pn * 256 + wc * 32 + 4 * fq;
        const float* gp = gate + (size_t)r * 6 * D + col0;
        pg8::f32x4 gv[2][2];
#pragma unroll
        for (int bj = 0; bj < 2; ++bj)
#pragma unroll
            for (int n = 0; n < 2; ++n) gv[bj][n] = *(const pg8::f32x4*)(gp + bj * 128 + n * 16);
#pragma unroll
        for (int ai = 0; ai < 2; ++ai)
#pragma unroll
            for (int m = 0; m < 4; ++m) {
                const int rl = ai * 128 + wr * 64 + m * 16 + fr, t = u.pm * 256 + rl;
                const float* sp = j == 0 ? ctx + ((size_t)b * CTX + rl) * D : x + ((size_t)b * SEQ + (j - 1) * 256 + rl) * D;
                bf16* op = xres + (size_t)t * D;
#pragma unroll
                for (int bj = 0; bj < 2; ++bj)
#pragma unroll
                    for (int n = 0; n < 2; ++n) { const int cc = col0 + bj * 128 + n * 16; pg8::f32x4 s;
                        if (layer0) s = *(const pg8::f32x4*)(sp + cc); else { const v2u sb = *(const v2u*)(op + cc); s = (pg8::f32x4){bflo(sb.x), bfhi(sb.x), bflo(sb.y), bfhi(sb.y)}; }
                        const pg8::f32x4 o = s + gv[bj][n] * acc[ai][bj][m][n]; v2u ob; ob.x = pk2(o[0], o[1]); ob.y = pk2(o[2], o[3]); *(v2u*)(op + cc) = ob; }
            }
    }
};
struct EpiSwiglu {
    static constexpr bool PERM = true, AFTER_DRAIN = false, LDS_BIAS = true;
    unsigned char* act; const float* b_gu  ; const int* base;
    __device__ __forceinline__ void stage_bias(const pg8::Unit& u, LAS unsigned char* lds, int wid, int lane) const {
        const int e = u.pn >> 3, pn = u.pn & 7;
        __builtin_amdgcn_global_load_lds((const unsigned*)(b_gu + (size_t)e * 2 * DFF + 256 * pn + 64 * (wid & 3) + lane), (LAS unsigned*)(lds + LDS_BIAS_OFF + (wid >> 2) * 1024 + (wid & 3) * 256), 4, 0, 0);
    }
    __device__ __forceinline__ void operator()(const pg8::f32x4 (&acc)[2][2][4][2], const pg8::Unit& u, int wr, int wc, int fr, int fq) const {
        const int ln_ = tid_fresh() & 63; fr = ln_ & 15; fq = ln_ >> 4;
        const int e = u.pn >> 3, pn = u.pn & 7, j0 = 128 * pn + 32 * wc + 8 * fq;
        const int rowblk = (__builtin_amdgcn_readfirstlane(base[e]) >> 8) + (u.pm - e * (T / 256));
        extern __shared__ __attribute__((aligned(16))) unsigned char lds_raw_e[];
        const LAS float* bp = (const LAS float*)((LAS unsigned char*)lds_raw_e + LDS_BIAS_OFF) + wr * 256 + 64 * wc + 16 * fq;
#pragma unroll
        for (int n = 0; n < 2; ++n) {
            const pg8::f32x4 b0 = *(const LAS pg8::f32x4*)(bp + 8 * n), b1 = *(const LAS pg8::f32x4*)(bp + 8 * n + 4);
            typedef float sw_f2 __attribute__((ext_vector_type(2)));
            const sw_f2 gb2[2] = {{b0[0], b0[2]}, {b1[0], b1[2]}}, ub2[2] = {{b0[1] + 1.f, b0[3] + 1.f}, {b1[1] + 1.f, b1[3] + 1.f}};
#pragma unroll
            for (int ai = 0; ai < 2; ++ai)
#pragma unroll
                for (int m = 0; m < 4; ++m) {
                    const int row = rowblk * 256 + ai * 128 + wr * 64 + m * 16 + fr;
                    sw_f2 o[2];
#pragma unroll
                    for (int h = 0; h < 2; ++h) {
                        sw_f2 g = (sw_f2){acc[ai][0][m][n][2 * h], acc[ai][0][m][n][2 * h + 1]} * WSCALE_INV + gb2[h];
                        sw_f2 u = (sw_f2){acc[ai][1][m][n][2 * h], acc[ai][1][m][n][2 * h + 1]} * WSCALE_INV + ub2[h];
                        g.x = fminf(g.x, 7.f); g.y = fminf(g.y, 7.f);
                        u.x = __builtin_amdgcn_fmed3f(u.x, -6.f, 8.f); u.y = __builtin_amdgcn_fmed3f(u.y, -6.f, 8.f);
                        sw_f2 e = g * (-1.702f * 1.44269504089f);
                        e.x = __builtin_amdgcn_exp2f(e.x); e.y = __builtin_amdgcn_exp2f(e.y);
                        e = e + 1.f;
                        sw_f2 r; r.x = __builtin_amdgcn_rcpf(e.x); r.y = __builtin_amdgcn_rcpf(e.y);
                        o[h] = (u * g) * r;
                    }
                    *(unsigned*)(act + (size_t)row * DFF + j0 + 4 * n) = pk4_f8(o[0].x, o[0].y, o[1].x, o[1].y);
                }
            asm volatile("" ::: "memory");
        }
    }
};
struct EpiDown {
    static constexpr bool PERM = true, AFTER_DRAIN = false, LDS_BIAS = true;
    bf16* yb; const float* b_dn  ;
    __device__ __forceinline__ void stage_bias(const pg8::Unit& u, LAS unsigned char* lds, int wid, int lane) const {
        const int e = u.pn >> 2, pn = u.pn & 3;
        __builtin_amdgcn_global_load_lds((const unsigned*)(b_dn + (size_t)e * D + 256 * pn + 64 * (wid & 3) + lane), (LAS unsigned*)(lds + LDS_BIAS_OFF + (wid >> 2) * 1024 + (wid & 3) * 256), 4, 0, 0);
    }
    __device__ __forceinline__ void operator()(const pg8::f32x4 (&acc)[2][2][4][2], const pg8::Unit& u, int wr, int wc, int fr, int fq) const {
        const int ln_ = tid_fresh() & 63; fr = ln_ & 15; fq = ln_ >> 4;
        const int e = u.pn >> 2, pn = u.pn & 3, col0 = 256 * pn + 32 * wc + 8 * fq;
        extern __shared__ __attribute__((aligned(16))) unsigned char lds_raw_e[];
        const LAS float* bp = (const LAS float*)((LAS unsigned char*)lds_raw_e + LDS_BIAS_OFF) + wr * 256 + 32 * wc + 8 * fq;
        pg8::f32x4 bv[2][2];
#pragma unroll
        for (int bj = 0; bj < 2; ++bj)
#pragma unroll
            for (int n = 0; n < 2; ++n) bv[bj][n] = *(const LAS pg8::f32x4*)(bp + bj * 128 + 4 * n);
#pragma unroll
        for (int ai = 0; ai < 2; ++ai)
#pragma unroll
            for (int m = 0; m < 4; ++m) {
                const int row = u.pm * 256 + ai * 128 + wr * 64 + m * 16 + fr;
#pragma unroll
                for (int bj = 0; bj < 2; ++bj) { const pg8::f32x4 v0 = acc[ai][bj][m][0] * WSCALE_INV + bv[bj][0], v1 = acc[ai][bj][m][1] * WSCALE_INV + bv[bj][1];
                    pg8::u32x4 w; w.x = pg8::cvt_pk_bf16(v0[0], v0[1]); w.y = pg8::cvt_pk_bf16(v0[2], v0[3]); w.z = pg8::cvt_pk_bf16(v1[0], v1[1]); w.w = pg8::cvt_pk_bf16(v1[2], v1[3]);
                    *(pg8::u32x4*)(yb + (size_t)row * D + col0 + bj * 128) = w; }
            }
    }
};

__device__ __forceinline__ void ph_gemm_in(CP p, LAS unsigned char* lds, int layer) {
    const int N = layer ? LDP1 : LDP0;
    pg8::Gemm g{p.hb, layer ? p.wt_in1 : p.wt_in0, T, N, D}; pg8::StaticOrder S; S.init(T, N, gridDim.x, blockIdx.x);
    pg8::EpiBf16<0> E{p.P, N, nullptr, 0, 0, 1.f};
    pg8::gemm_phase<pg8::EpiBf16<0>, pg8::StaticOrder, PG8_ALIGN, PG8_SP2>(lds, g, S, E);
    if (layer) ph_fill(p, lds, FILL_IN1); else ph_fill(p, lds, FILL_IN0);
}
__device__ __forceinline__ void ph_gemm_out(CP p, LAS unsigned char* lds, int layer) {
    EpiResid E{p.x, p.ctx, (bf16*)p.xres, p.mod + (size_t)layer * 5 * 6 * D + 2 * D, layer == 0 ? 1 : 0};
    if (layer == 0) { pg8::Gemm g{p.merged, p.wt_out0, T, D, D}; pg8::StaticOrder S; S.init(T, D, gridDim.x, blockIdx.x);
        pg8::gemm_phase<EpiResid, pg8::StaticOrder, PG8_ALIGN, PG8_SP2>(lds, g, S, E); ph_fill(p, lds, FILL_OUT0); }
    else { pg8::Gemm g{p.merged, p.wt_out1, T, D, 2 * D}; LatOrder S{(int)gridDim.x, (int)blockIdx.x};
        pg8::gemm_phase<EpiResid, LatOrder, PG8_ALIGN, PG8_SP2>(lds, g, S, E); }
}
__device__ __forceinline__ void ph_moe_gu(CP p, LAS unsigned char* lds, int layer, const int* base) {
    pg8::Gemm g{(const pg8::bf16_t*)p.hs, (const pg8::bf16_t*)((const unsigned char*)p.wt_gu + (size_t)layer * NE * 2 * DFF * D), NE * T, 2 * DFF, D / 2}; MoeCapOrder S{base, 8, (int)gridDim.x, (int)blockIdx.x};
    EpiSwiglu E{(unsigned char*)p.act, p.moe_b_gu + (size_t)layer * NE * 2 * DFF, base};
    pg8::gemm_phase<EpiSwiglu, MoeCapOrder, PG8_ALIGN, PG8_SP2, false, true>(lds, g, S, E);
    if (layer == 0) ph_fill(p, lds, FILL_GU0);
}
__device__ __forceinline__ void ph_moe_dn(CP p, LAS unsigned char* lds, int layer, const int* base) {
    pg8::Gemm g{(const pg8::bf16_t*)p.act, (const pg8::bf16_t*)((const unsigned char*)p.wt_dn + (size_t)layer * NE * D * DFF), MOE_ROWS, D, DFF / 2}; MoeOrder S{base, 4, (int)gridDim.x, (int)blockIdx.x};
    EpiDown E{p.yb, p.moe_b_dn + (size_t)layer * NE * D};
    pg8::gemm_phase<EpiDown, MoeOrder, PG8_ALIGN, PG8_SP2, false, true>(lds, g, S, E);
    if (layer == 0) ph_fill(p, lds, FILL_DN0);
}

constexpr int PQ = 136, PS = 72;
__device__ __forceinline__ bf16x8 ldfrag(const LAS bf16* base, int pitch, int row0, int k0, int lane) { return *(const LAS bf16x8*)(base + (row0 + (lane & 15)) * pitch + k0 + 8 * (lane >> 4)); }
typedef short s16x4 __attribute__((ext_vector_type(4)));
__device__ __forceinline__ bf16x8 ldfrag_tr(const LAS bf16* base, int pitch, int m0, int k0, int lane) {
    const LAS bf16* a0 = base + (k0 + 8 * (lane >> 4) + ((lane & 15) >> 2)) * pitch + m0 + 4 * (lane & 3);
    const s16x4 lo = __builtin_amdgcn_ds_read_tr16_b64_v4i16((LAS s16x4*)a0);
    const s16x4 hi = __builtin_amdgcn_ds_read_tr16_b64_v4i16((LAS s16x4*)(a0 + 4 * pitch));
    return (bf16x8){lo[0], lo[1], lo[2], lo[3], hi[0], hi[1], hi[2], hi[3]};
}
#define MFMA16(x, y, acc) __builtin_amdgcn_mfma_f32_16x16x32_bf16(x, y, acc, 0, 0, 0)
__device__ __forceinline__ int chunk_of_step(int j, int d) { return d == 0 ? j : (j < 4 ? 3 - j : 71 - j); }

__device__ __forceinline__ void ph_ret_scan(CP p, LAS unsigned char* lds) {
    const int tid = tid_fresh(), lane = tid & 63, w = __builtin_amdgcn_readfirstlane(tid >> 6), r16 = lane & 15, q4 = lane >> 4;
    LAS bf16* Qs = (LAS bf16*)lds;
    LAS bf16* Ks = Qs + 64 * PQ;
    LAS bf16* Vs = Ks + 64 * PQ;
    LAS bf16* Vts = Vs + 64 * PS;
    LAS bf16* Ps = Vts + 64 * PS;
    LAS bf16* St = Ps + 64 * PS;
    const bf16* Pm = p.P; const float* rope = p.rope; bf16* od = p.od;
    for (int item = bid_fresh(); item < 256; item += gridDim.x) {
        const int sl = item & 3, d = (item >> 2) & 1, h = (item >> 3) & 7, b = item >> 6;
        const float lg2 = log2f(1.f - exp2f(-(5.f + (float)(d ? 7 - h : h))));
        const float g64 = exp2f(64.f * lg2);
        f32x4 S[4];
#pragma unroll
        for (int n = 0; n < 4; ++n) S[n] = (f32x4){0.f, 0.f, 0.f, 0.f};
        asm volatile("" : "+v"(S[0]), "+v"(S[1]), "+v"(S[2]), "+v"(S[3]));
        v4u A_rq0, A_rq1, A_rk0, A_rk1, A_rv, B_rq0, B_rq1, B_rk0, B_rk1, B_rv; f32x4 A_c0, A_c1, A_c2, A_c3, B_c0, B_c1, B_c2, B_c3;
        const int mr = tid >> 3, cc = tid & 7, ir = d ? 63 - mr : mr;
#define RET_LOAD(jj, X) do { const int pos_ = 64 * (jj) + mr; const bf16* row_ = Pm + (size_t)(b * TPB + pos_) * LDP1; \
            X##rq0 = *(const v4u*)(row_ + C_RQ + h * 128 + 8 * cc); X##rq1 = *(const v4u*)(row_ + C_RQ + h * 128 + 64 + 8 * cc); \
            X##rk0 = *(const v4u*)(row_ + C_RK + h * 128 + 8 * cc); X##rk1 = *(const v4u*)(row_ + C_RK + h * 128 + 64 + 8 * cc); \
            X##rv = *(const v4u*)(row_ + C_RV + h * 256 + sl * 64 + 8 * cc); \
            const f32x4* rp_ = (const f32x4*)(rope + ((size_t)pos_ * 64 + 8 * cc) * 2); X##c0 = rp_[0]; X##c1 = rp_[1]; X##c2 = rp_[2]; X##c3 = rp_[3]; } while (0)
        RET_LOAD(chunk_of_step(0, d), A_); RET_LOAD(chunk_of_step(1, d), B_);
        const float tail = exp2f(lg2 * (float)(63 - ir));
#define RET_STEP(j, X, Y) do { \
            const int jj = chunk_of_step(j, d); \
            LDS_BARRIER(); \
            { \
                const unsigned qa[4] = {X##rq0.x, X##rq0.y, X##rq0.z, X##rq0.w}, qb[4] = {X##rq1.x, X##rq1.y, X##rq1.z, X##rq1.w}, ka[4] = {X##rk0.x, X##rk0.y, X##rk0.z, X##rk0.w}, kb[4] = {X##rk1.x, X##rk1.y, X##rk1.z, X##rk1.w}, va[4] = {X##rv.x, X##rv.y, X##rv.z, X##rv.w}; \
                const f32x4 cs[4] = {X##c0, X##c1, X##c2, X##c3}; \
                unsigned oq0[4], oq1[4], ok0[4], ok1[4], ovt[4]; \
_Pragma("unroll") \
                for (int u = 0; u < 4; ++u) { \
                    const float cA = cs[u].x, sA = cs[u].y, cB = cs[u].z, sB = cs[u].w; \
                    const float q0a = bflo(qa[u]), q0b = bfhi(qa[u]), q1a = bflo(qb[u]), q1b = bfhi(qb[u]); \
                    const float k0a = bflo(ka[u]) * 0.08838834764831845f, k0b = bfhi(ka[u]) * 0.08838834764831845f, k1a = bflo(kb[u]) * 0.08838834764831845f, k1b = bfhi(kb[u]) * 0.08838834764831845f; \
                    oq0[u] = pk2(q0a * cA - q1a * sA, q0b * cB - q1b * sB); oq1[u] = pk2(q0a * sA + q1a * cA, q0b * sB + q1b * cB); \
                    ok0[u] = pk2(k0a * cA - k1a * sA, k0b * cB - k1b * sB); ok1[u] = pk2(k0a * sA + k1a * cA, k0b * sB + k1b * cB); \
                    ovt[u] = pk2(bflo(va[u]) * tail, bfhi(va[u]) * tail); \
                } \
                *(LAS v4u*)(Qs + ir * PQ + 8 * cc) = (v4u){oq0[0], oq0[1], oq0[2], oq0[3]}; *(LAS v4u*)(Qs + ir * PQ + 64 + 8 * cc) = (v4u){oq1[0], oq1[1], oq1[2], oq1[3]}; \
                *(LAS v4u*)(Ks + ir * PQ + 8 * cc) = (v4u){ok0[0], ok0[1], ok0[2], ok0[3]}; *(LAS v4u*)(Ks + ir * PQ + 64 + 8 * cc) = (v4u){ok1[0], ok1[1], ok1[2], ok1[3]}; \
                *(LAS v4u*)(Vs + ir * PS + 8 * cc) = X##rv; *(LAS v4u*)(Vts + ir * PS + 8 * cc) = (v4u){ovt[0], ovt[1], ovt[2], ovt[3]}; \
_Pragma("unroll") \
                for (int n = 0; n < 4; ++n) { v2u o; o.x = pk2(S[n][0], S[n][1]); o.y = pk2(S[n][2], S[n][3]); *(LAS v2u*)(St + (16 * n + r16) * PQ + 16 * w + 4 * q4) = o; } \
            } \
            LDS_BARRIER(); \
            if (j + 2 < 68) RET_LOAD(chunk_of_step(j + 2, d), X); \
            const int ct = w >> 1, h2 = (w & 1) * 2; \
            bf16x8 qf[4]; \
_Pragma("unroll") \
            for (int ks = 0; ks < 4; ++ks) qf[ks] = ldfrag(Qs, PQ, 16 * ct, 32 * ks, lane); \
            { \
                f32x4 a0 = {0.f, 0.f, 0.f, 0.f}, a1 = {0.f, 0.f, 0.f, 0.f}; \
                if (h2 <= ct) { \
_Pragma("unroll") \
                    for (int ks = 0; ks < 4; ++ks) { const bf16x8 a = qf[ks]; a0 = MFMA16(ldfrag(Ks, PQ, 16 * h2, 32 * ks, lane), a, a0); a1 = MFMA16(ldfrag(Ks, PQ, 16 * (h2 + 1), 32 * ks, lane), a, a1); } \
                } \
                const int c = 16 * ct + r16; \
_Pragma("unroll") \
                for (int n = 0; n < 2; ++n) { const f32x4 a = n ? a1 : a0; float o[4]; \
_Pragma("unroll") \
                    for (int i = 0; i < 4; ++i) { const int s = 16 * (h2 + n) + 4 * q4 + i; o[i] = c >= s ? a[i] * __builtin_amdgcn_exp2f(lg2 * (float)(c - s)) : 0.f; } \
                    v2u pk; pk.x = pk2(o[0], o[1]); pk.y = pk2(o[2], o[3]); *(LAS v2u*)(Ps + c * PS + 16 * (h2 + n) + 4 * q4) = pk; } \
            } \
            f32x4 b0 = {0.f, 0.f, 0.f, 0.f}, b1 = {0.f, 0.f, 0.f, 0.f}; \
            if (jj >= 4) { \
_Pragma("unroll") \
                for (int ks = 0; ks < 4; ++ks) { const bf16x8 a = qf[ks]; b0 = MFMA16(ldfrag(St, PQ, 16 * h2, 32 * ks, lane), a, b0); b1 = MFMA16(ldfrag(St, PQ, 16 * (h2 + 1), 32 * ks, lane), a, b1); } \
            } \
            LDS_BARRIER(); \
            if (jj >= 4) { \
                f32x4 a0 = {0.f, 0.f, 0.f, 0.f}, a1 = {0.f, 0.f, 0.f, 0.f}; \
_Pragma("unroll") \
                for (int ks = 0; ks < 2; ++ks) { const bf16x8 a = ldfrag(Ps, PS, 16 * ct, 32 * ks, lane); a0 = MFMA16(ldfrag_tr(Vs, PS, 16 * h2, 32 * ks, lane), a, a0); a1 = MFMA16(ldfrag_tr(Vs, PS, 16 * (h2 + 1), 32 * ks, lane), a, a1); } \
                const int c = 16 * ct + r16, mm = d ? 63 - c : c; const float cr = __builtin_amdgcn_exp2f(lg2 * (float)(c + 1)); \
                bf16* orow = od + ((size_t)d * T + b * TPB + 64 * jj + mm) * 2048 + h * 256 + sl * 64 + 4 * q4; \
                { v2u o; o.x = pk2(a0[0] + cr * b0[0], a0[1] + cr * b0[1]); o.y = pk2(a0[2] + cr * b0[2], a0[3] + cr * b0[3]); *(v2u*)(orow + 16 * h2) = o; } \
                { v2u o; o.x = pk2(a1[0] + cr * b1[0], a1[1] + cr * b1[1]); o.y = pk2(a1[2] + cr * b1[2], a1[3] + cr * b1[3]); *(v2u*)(orow + 16 * (h2 + 1)) = o; } \
            } \
            { \
_Pragma("unroll") \
                for (int n = 0; n < 4; ++n) S[n] = S[n] * g64; \
_Pragma("unroll") \
                for (int ks = 0; ks < 2; ++ks) { const bf16x8 a = ldfrag_tr(Ks, PQ, 16 * w, 32 * ks, lane); \
_Pragma("unroll") \
                    for (int n = 0; n < 4; ++n) S[n] = MFMA16(a, ldfrag_tr(Vts, PS, 16 * n, 32 * ks, lane), S[n]); } \
            } \
} while (0)
        for (int j = 0; j < 68; j += 2) { RET_STEP(j, A_, B_); RET_STEP(j + 1, B_, A_); }
#undef RET_LOAD
    }
}
__device__ __forceinline__ void ph_merge_odd(CP p) {
    const int tid = tid_fresh(), h = tid >> 6, lane = tid & 63;
    const bf16* od = p.od + h * 256 + lane * 4; const bf16* gp = p.P + C_RG + h * 256 + lane * 4;
    const f32x4 ng = *(const f32x4*)(p.ret_norm_g + h * 256 + lane * 4);
    for (int l0 = blockIdx.x * 4; l0 < NB * SEQ; l0 += gridDim.x * 4) {
        v2u va[4], vb[4], vg[4];
#pragma unroll
        for (int u = 0; u < 4; ++u) { const int tl = l0 + u; const size_t t = (size_t)(tl >> 12) * TPB + CTX + (tl & 4095);
            va[u] = *(const v2u*)(od + t * 2048); vb[u] = *(const v2u*)(od + t * 2048 + (size_t)T * 2048); vg[u] = *(const v2u*)(gp + t * LDP1); }
#pragma unroll
        for (int u = 0; u < 4; ++u) { const int tl = l0 + u; const size_t t = (size_t)(tl >> 12) * TPB + CTX + (tl & 4095);
            f32x4 v; v.x = bflo(va[u].x) + bflo(vb[u].x); v.y = bfhi(va[u].x) + bfhi(vb[u].x); v.z = bflo(va[u].y) + bflo(vb[u].y); v.w = bfhi(va[u].y) + bfhi(vb[u].y);
            const float mean = wave_sum((v.x + v.y) + (v.z + v.w)) * (1.f / 256.f);
            v = v - mean;
            const float rs = rsqrtf(wave_sum((v.x * v.x + v.y * v.y) + (v.z * v.z + v.w * v.w)) * (1.f / 256.f) + EPS);
            v2u o; o.x = pk2(v.x * rs * ng.x * siluf_(bflo(vg[u].x)), v.y * rs * ng.y * siluf_(bfhi(vg[u].x))); o.y = pk2(v.z * rs * ng.z * siluf_(bflo(vg[u].y)), v.w * rs * ng.w * siluf_(bfhi(vg[u].y)));
            *(v2u*)(p.merged + t * 2048 + h * 256 + lane * 4) = o; }
    }
}

constexpr int PV = 56;
__device__ __forceinline__ void ph_mlstm_scan(CP p, LAS unsigned char* lds, int first_block, int nblocks) {
    const int tid = tid_fresh(), lane = tid & 63, w = __builtin_amdgcn_readfirstlane(tid >> 6), r16 = lane & 15, q4 = lane >> 4;
    LAS bf16* Qs = (LAS bf16*)lds;
    LAS bf16* Ks = Qs + 64 * PQ;
    LAS bf16* Vs = Ks + 64 * PQ;
    LAS bf16* Vts = Vs + 64 * PV;
    LAS bf16* Ps = Vts + 64 * PV;
    LAS bf16* St = Ps + 64 * PS;
    LAS float* gt = (LAS float*)(St + 48 * PQ);
    const bf16* Pm = p.P; bf16* om = (bf16*)p.scr1 + (size_t)2 * T * 512;
    const int bx0 = bid_fresh();
    for (int item = bx0 >= first_block ? bx0 - first_block : 128; item < 128; item += nblocks) {
        const int sl = item & 3, d = (item >> 2) & 1, h = (item >> 3) & 3, b = item >> 5;
        const float ibias = p.ml_i_bias[d * 4 + h], fbias = p.ml_f_bias[d * 4 + h];
        f32x4 S[3];
#pragma unroll
        for (int n = 0; n < 3; ++n) S[n] = (f32x4){0.f, 0.f, 0.f, 0.f};
        asm volatile("" : "+v"(S[0]), "+v"(S[1]), "+v"(S[2]));
        __syncthreads();
        for (int i = tid; i < 2 * 64 * PV; i += NTHR) Vs[i] = (bf16)0;
        v4u A_rq0, A_rq1, A_rk0, A_rk1, A_rv, B_rq0, B_rq1, B_rk0, B_rk1, B_rv; unsigned short A_rgi, A_rgf, B_rgi, B_rgf;
        const int mr = tid >> 3, cc = tid & 7, ir = d ? 63 - mr : mr;
        const int mg = d ? 63 - lane : lane;
#define ML_LOAD(jj, X) do { const bf16* row_ = Pm + (size_t)(b * TPB + 64 * (jj) + mr) * LDP0; \
            X##rq0 = *(const v4u*)(row_ + C_MQ + h * 128 + 8 * cc); X##rq1 = *(const v4u*)(row_ + C_MQ + h * 128 + 64 + 8 * cc); \
            X##rk0 = *(const v4u*)(row_ + C_MK + h * 128 + 8 * cc); X##rk1 = *(const v4u*)(row_ + C_MK + h * 128 + 64 + 8 * cc); \
            if (cc < 4) X##rv = *(const v4u*)(row_ + C_MV + h * 128 + sl * 32 + 8 * cc); \
            if (w == 1) { const bf16* rg_ = Pm + (size_t)(b * TPB + 64 * (jj) + mg) * LDP0; X##rgi = rg_[C_IG + d * 4 + h]; X##rgf = rg_[C_FG + d * 4 + h]; } } while (0)
#define ML_GATES(gi_, gf_, tab_) do { const float li_ = bf2f(gi_) + ibias; float bc_ = -softplusf_(-(bf2f(gf_) + fbias)); \
            _Pragma("unroll") for (int o_ = 1; o_ < 64; o_ <<= 1) { const float t_ = __shfl_up(bc_, o_); if (lane >= o_) bc_ += t_; } \
            const float b63_ = __shfl(bc_, 63); (tab_)[lane] = bc_; (tab_)[64 + lane] = li_; (tab_)[128 + lane] = __expf(b63_ - bc_ + li_); } while (0)
        ML_LOAD(chunk_of_step(0, d), A_); ML_LOAD(chunk_of_step(1, d), B_);
        if (w == 1) ML_GATES(A_rgi, A_rgf, gt);
#define ML_STEP(j, X, Y) do { \
            const int jj = chunk_of_step(j, d); \
            LAS float* g0 = gt + ((j) & 1) * 192; \
            LDS_BARRIER(); \
            { \
                const float wend = g0[128 + ir]; \
                const unsigned ka[4] = {X##rk0.x, X##rk0.y, X##rk0.z, X##rk0.w}, kb[4] = {X##rk1.x, X##rk1.y, X##rk1.z, X##rk1.w}, va[4] = {X##rv.x, X##rv.y, X##rv.z, X##rv.w}; \
                unsigned ok0[4], ok1[4], ov[4]; \
_Pragma("unroll") \
                for (int u = 0; u < 4; ++u) { \
                    ok0[u] = pk2(bflo(ka[u]) * 0.08838834764831845f, bfhi(ka[u]) * 0.08838834764831845f); ok1[u] = pk2(bflo(kb[u]) * 0.08838834764831845f, bfhi(kb[u]) * 0.08838834764831845f); \
                    ov[u] = pk2(bflo(va[u]) * wend, bfhi(va[u]) * wend); \
                } \
                *(LAS v4u*)(Qs + ir * PQ + 8 * cc) = X##rq0; *(LAS v4u*)(Qs + ir * PQ + 64 + 8 * cc) = X##rq1; \
                *(LAS v4u*)(Ks + ir * PQ + 8 * cc) = (v4u){ok0[0], ok0[1], ok0[2], ok0[3]}; *(LAS v4u*)(Ks + ir * PQ + 64 + 8 * cc) = (v4u){ok1[0], ok1[1], ok1[2], ok1[3]}; \
                if (cc < 4) { *(LAS v4u*)(Vs + ir * PV + 8 * cc) = X##rv; *(LAS v4u*)(Vts + ir * PV + 8 * cc) = (v4u){ov[0], ov[1], ov[2], ov[3]}; } \
                if (cc == 4) { Vs[ir * PV + 32] = (bf16)0x3F80u; Vts[ir * PV + 32] = (bf16)f2bf(wend); } \
_Pragma("unroll") \
                for (int n = 0; n < 3; ++n) { v2u o; o.x = pk2(S[n][0], S[n][1]); o.y = pk2(S[n][2], S[n][3]); *(LAS v2u*)(St + (16 * n + r16) * PQ + 16 * w + 4 * q4) = o; } \
            } \
            LDS_BARRIER(); \
            if (w == 1) ML_GATES(Y##rgi, Y##rgf, gt + (((j) + 1) & 1) * 192); \
            if (j + 2 < 68) ML_LOAD(chunk_of_step(j + 2, d), X); \
            const int ct = w >> 1, h2 = (w & 1) * 2; \
            bf16x8 qf[4]; \
_Pragma("unroll") \
            for (int ks = 0; ks < 4; ++ks) qf[ks] = ldfrag(Qs, PQ, 16 * ct, 32 * ks, lane); \
            { \
                f32x4 a0 = {0.f, 0.f, 0.f, 0.f}, a1 = {0.f, 0.f, 0.f, 0.f}; \
                if (h2 <= ct) { \
_Pragma("unroll") \
                    for (int ks = 0; ks < 4; ++ks) { const bf16x8 a = qf[ks]; a0 = MFMA16(ldfrag(Ks, PQ, 16 * h2, 32 * ks, lane), a, a0); a1 = MFMA16(ldfrag(Ks, PQ, 16 * (h2 + 1), 32 * ks, lane), a, a1); } \
                } \
                const int c = 16 * ct + r16; const float bcr = g0[c]; \
_Pragma("unroll") \
                for (int n = 0; n < 2; ++n) { const f32x4 a = n ? a1 : a0; float o[4]; \
_Pragma("unroll") \
                    for (int i = 0; i < 4; ++i) { const int s = 16 * (h2 + n) + 4 * q4 + i; o[i] = c >= s ? a[i] * __expf(bcr - g0[s] + g0[64 + s]) : 0.f; } \
                    v2u pk; pk.x = pk2(o[0], o[1]); pk.y = pk2(o[2], o[3]); *(LAS v2u*)(Ps + c * PS + 16 * (h2 + n) + 4 * q4) = pk; } \
            } \
            const int hv = w & 1; \
            f32x4 b0 = {0.f, 0.f, 0.f, 0.f}, b1 = {0.f, 0.f, 0.f, 0.f}; \
_Pragma("unroll") \
            for (int ks = 0; ks < 4; ++ks) { const bf16x8 a = qf[ks]; b0 = MFMA16(ldfrag(St, PQ, 16 * hv, 32 * ks, lane), a, b0); b1 = MFMA16(ldfrag(St, PQ, 32, 32 * ks, lane), a, b1); } \
            LDS_BARRIER(); \
            { \
                f32x4 a0 = {0.f, 0.f, 0.f, 0.f}, a1 = {0.f, 0.f, 0.f, 0.f}; \
_Pragma("unroll") \
                for (int ks = 0; ks < 2; ++ks) { const bf16x8 a = ldfrag(Ps, PS, 16 * ct, 32 * ks, lane); a0 = MFMA16(ldfrag_tr(Vs, PV, 16 * hv, 32 * ks, lane), a, a0); a1 = MFMA16(ldfrag_tr(Vs, PV, 32, 32 * ks, lane), a, a1); } \
                const int c = 16 * ct + r16, mm = d ? 63 - c : c; const float eb = __expf(g0[c]); \
                const float den_l = a1[0] + eb * b1[0]; \
                const float den = fmaxf(fabsf(__shfl(den_l, r16)), 1.f), rd = __builtin_amdgcn_rcpf(den); \
                bf16* orow = om + ((size_t)d * T + b * TPB + 64 * jj + mm) * 512 + h * 128 + sl * 32 + 16 * hv + 4 * q4; \
                v2u o; o.x = pk2((a0[0] + eb * b0[0]) * rd, (a0[1] + eb * b0[1]) * rd); o.y = pk2((a0[2] + eb * b0[2]) * rd, (a0[3] + eb * b0[3]) * rd); \
                *(v2u*)orow = o; \
            } \
            { \
                const float e63 = __expf(g0[63]); \
_Pragma("unroll") \
                for (int n = 0; n < 3; ++n) S[n] = S[n] * e63; \
_Pragma("unroll") \
                for (int ks = 0; ks < 2; ++ks) { const bf16x8 a = ldfrag_tr(Ks, PQ, 16 * w, 32 * ks, lane); \
_Pragma("unroll") \
                    for (int n = 0; n < 3; ++n) S[n] = MFMA16(a, ldfrag_tr(Vts, PV, 16 * n, 32 * ks, lane), S[n]); } \
            } \
} while (0)
        for (int j = 0; j < 68; j += 2) { ML_STEP(j, A_, B_); ML_STEP(j + 1, B_, A_); }
#undef ML_LOAD
#undef ML_GATES
    }
}

constexpr size_t GDN_REC = 2 * 4 * NB * 68;
struct GdnBufs { bf16 *W, *UT, *Qd, *KdT, *QKm; float* cd; };
__device__ __forceinline__ GdnBufs gdn_bufs(CP p) { GdnBufs g; bf16* base = (bf16*)p.scr0; g.W = base; g.UT = g.W + GDN_REC * 8192; g.Qd = g.UT + GDN_REC * 8192; g.KdT = g.Qd + GDN_REC * 8192; g.QKm = g.KdT + GDN_REC * 8192; g.cd = (float*)(g.QKm + GDN_REC * 4096); return g; }

__device__ __forceinline__ void ph_gdn_local(CP p, LAS unsigned char* lds) {
    LAS bf16* Qs = (LAS bf16*)lds;
    LAS bf16* Ks = Qs + 64 * PQ;
    LAS bf16* Vs = Ks + 64 * PQ;
    LAS float* Ls = (LAS float*)(Vs + 64 * PQ);
    LAS bf16* Wst = (LAS bf16*)(Ls + 2 * 64 * 68);
    LAS float* ssq = (LAS float*)(Wst + 2 * 64 * PQ);
    LAS float* sg = ssq + 2 * 64 * 8;
    LAS float* scu = sg + 128;
    LAS float* scw = scu + 128;
    const GdnBufs gb = gdn_bufs(p);
    const bf16* Pm = p.P; const float* cw = p.ev_conv_w;
    for (int unit = bid_fresh(); unit < NB * 68 * 4; unit += gridDim.x) {
        const int tid = tid_fresh(), lane = tid & 63, w = __builtin_amdgcn_readfirstlane(tid >> 6), r16 = lane & 15, q4 = lane >> 4;
        const int h = unit & 3, bj = unit >> 2, jj = bj % 68, b = bj / 68;
        const int m = tid >> 3, cc = tid & 7, t = b * TPB + 64 * jj + m;
        const bool hp = (m > 0) || (jj > 0 && jj < 4), hn = (m < 63) || (jj < 3);
        LDS_BARRIER();
        for (int i = tid; i < 2 * 64 * 68; i += NTHR) Ls[i] = 0.f;
        float y[6][8];
#pragma unroll
        for (int ck = 0; ck < 6; ++ck) {
            const int col = (ck >> 1) * 512 + h * 128 + (ck & 1) * 64 + 8 * cc;
            const bf16* pc = Pm + (size_t)t * LDP0 + col;
            const v4u u1 = *(const v4u*)pc; v4u u0 = {0u, 0u, 0u, 0u}, u2 = {0u, 0u, 0u, 0u};
            if (hp) u0 = *(const v4u*)(pc - LDP0);
            if (hn) u2 = *(const v4u*)(pc + LDP0);
            const f32x4* w0 = (const f32x4*)(cw + col), *w1 = (const f32x4*)(cw + 1536 + col), *w2 = (const f32x4*)(cw + 3072 + col);
            const f32x4 w0a = w0[0], w0b = w0[1], w1a = w1[0], w1b = w1[1], w2a = w2[0], w2b = w2[1];
            const unsigned a0[4] = {u0.x, u0.y, u0.z, u0.w}, a1[4] = {u1.x, u1.y, u1.z, u1.w}, a2[4] = {u2.x, u2.y, u2.z, u2.w};
            const float wt0[8] = {w0a.x, w0a.y, w0a.z, w0a.w, w0b.x, w0b.y, w0b.z, w0b.w}, wt1[8] = {w1a.x, w1a.y, w1a.z, w1a.w, w1b.x, w1b.y, w1b.z, w1b.w}, wt2[8] = {w2a.x, w2a.y, w2a.z, w2a.w, w2b.x, w2b.y, w2b.z, w2b.w};
#pragma unroll
            for (int u = 0; u < 4; ++u) {
                y[ck][2 * u] = siluf_(wt0[2 * u] * bflo(a0[u]) + wt1[2 * u] * bflo(a1[u]) + wt2[2 * u] * bflo(a2[u]));
                y[ck][2 * u + 1] = siluf_(wt0[2 * u + 1] * bfhi(a0[u]) + wt1[2 * u + 1] * bfhi(a1[u]) + wt2[2 * u + 1] * bfhi(a2[u]));
            }
        }
        {
            float sq = 0.f, sk = 0.f;
#pragma unroll
            for (int e = 0; e < 8; ++e) { sq += y[0][e] * y[0][e] + y[1][e] * y[1][e]; sk += y[2][e] * y[2][e] + y[3][e] * y[3][e]; }
#pragma unroll
            for (int o = 1; o < 8; o <<= 1) { sq += __shfl_xor(sq, o); sk += __shfl_xor(sk, o); }
            const float rq = rsqrtf(sq + EPS) * 0.08838834764831845f, rk = rsqrtf(sk + EPS);
#pragma unroll
            for (int ck = 0; ck < 6; ++ck) { const float sc = ck < 2 ? rq : (ck < 4 ? rk : 1.f); LAS bf16* dst = (ck < 2 ? Qs : (ck < 4 ? Ks : Vs)) + m * PQ + (ck & 1) * 64 + 8 * cc;
                v4u o; o.x = pk2(y[ck][0] * sc, y[ck][1] * sc); o.y = pk2(y[ck][2] * sc, y[ck][3] * sc); o.z = pk2(y[ck][4] * sc, y[ck][5] * sc); o.w = pk2(y[ck][6] * sc, y[ck][7] * sc);
                *(LAS v4u*)dst = o; }
        }
        if (w < 2) {
            const int d = w, mi = d ? 63 - lane : lane; const bf16* row = Pm + (size_t)(b * TPB + 64 * jj + mi) * LDP0;
            const float la = -__expf(p.gdn_a_log[d * 4 + h]) * softplusf_(bf2f(row[C_AG + d * 4 + h]) + p.gdn_dt_bias[d * 4 + h]);
            const float be = sigmoidf_(bf2f(row[C_BG + d * 4 + h]));
            float g = la;
#pragma unroll
            for (int o = 1; o < 64; o <<= 1) { const float tt = __shfl_up(g, o); if (lane >= o) g += tt; }
            sg[d * 64 + lane] = g; scu[d * 64 + lane] = be; scw[d * 64 + lane] = be * __expf(g);
            if (lane == 63) gb.cd[((size_t)((b * 4 + h) * 2 + d)) * 68 + jj] = __expf(g);
        }
        LDS_BARRIER();
        {
            const int which = w >> 2, ct = w & 3; const LAS bf16* Am = which ? Qs : Ks;
            f32x4 acc[4];
#pragma unroll
            for (int n = 0; n < 4; ++n) acc[n] = (f32x4){0.f, 0.f, 0.f, 0.f};
#pragma unroll
            for (int ks = 0; ks < 4; ++ks) { const bf16x8 a = ldfrag(Am, PQ, 16 * ct, 32 * ks, lane);
#pragma unroll
                for (int n = 0; n < 4; ++n) acc[n] = MFMA16(ldfrag(Ks, PQ, 16 * n, 32 * ks, lane), a, acc[n]); }
            const int cm = 16 * ct + r16;
            const float g0c = sg[cm], g1c = sg[64 + 63 - cm], be0 = scu[cm], be1 = scu[64 + 63 - cm];
#pragma unroll
            for (int n = 0; n < 4; ++n) {
                float v0[4], v1[4];
#pragma unroll
                for (int e = 0; e < 4; ++e) { const int sm = 16 * n + 4 * q4 + e;
                    const float d0 = __expf(g0c - sg[sm]), d1 = __expf(g1c - sg[64 + 63 - sm]);
                    if (which == 0) { if (cm > sm) Ls[(0 * 64 + cm) * 68 + sm] = be0 * acc[n][e] * d0; if (cm < sm) Ls[(1 * 64 + 63 - cm) * 68 + 63 - sm] = be1 * acc[n][e] * d1; }
                    v0[e] = cm >= sm ? acc[n][e] * d0 : 0.f; v1[e] = cm <= sm ? acc[n][e] * d1 : 0.f; }
                if (which == 1) {
                    const size_t r0 = ((size_t)((b * 4 + h) * 2 + 0)) * 68 + jj, r1 = r0 + 68;
                    v2u o0; o0.x = pk2(v0[0], v0[1]); o0.y = pk2(v0[2], v0[3]); *(v2u*)(gb.QKm + r0 * 4096 + cm * 64 + 16 * n + 4 * q4) = o0;
                    v2u o1; o1.x = pk2(v1[3], v1[2]); o1.y = pk2(v1[1], v1[0]); *(v2u*)(gb.QKm + r1 * 4096 + (63 - cm) * 64 + 60 - 16 * n - 4 * q4) = o1;
                }
            }
        }
        LDS_BARRIER();
        if (tid < 256) {
            const int d = tid >> 7, c = tid & 127;
            const LAS float* cfu = scu + d * 64; const LAS float* cfw = scw + d * 64; const LAS float* Ld = Ls + d * 64 * 68;
            int sstride = d ? -PQ : PQ; asm volatile("" : "+v"(sstride));
            const LAS bf16* spv = Vs + c + (d ? 63 * PQ : 0); const LAS bf16* spk = Ks + c + (d ? 63 * PQ : 0);
            typedef float f32x2_ __attribute__((ext_vector_type(2)));
            f32x2_ X2[64];
#pragma unroll
            for (int i = 0; i < 64; ++i) {
                f32x2_ a0 = {cfu[i] * bf2f(spv[i * sstride]), cfw[i] * bf2f(spk[i * sstride])}, a1 = {0.f, 0.f};
#pragma unroll
                for (int j4 = 0; j4 < (i + 3) / 4; ++j4) { const f32x4 l = *(const LAS f32x4*)(Ld + i * 68 + 4 * j4);
                    a0 = a0 - l.x * X2[4 * j4];
                    if (4 * j4 + 1 < i) a1 = a1 - l.y * X2[4 * j4 + 1];
                    if (4 * j4 + 2 < i) a0 = a0 - l.z * X2[4 * j4 + 2];
                    if (4 * j4 + 3 < i) a1 = a1 - l.w * X2[4 * j4 + 3]; }
                X2[i] = a0 + a1;
                asm volatile("" ::: "memory");
            }
            const size_t rec = ((size_t)((b * 4 + h) * 2 + d)) * 68 + jj;
            { v4u* dst = (v4u*)(gb.UT + rec * 8192 + (size_t)c * 64);
#pragma unroll
                for (int q = 0; q < 8; ++q) { v4u o; o.x = pk2(X2[8 * q].x, X2[8 * q + 1].x); o.y = pk2(X2[8 * q + 2].x, X2[8 * q + 3].x); o.z = pk2(X2[8 * q + 4].x, X2[8 * q + 5].x); o.w = pk2(X2[8 * q + 6].x, X2[8 * q + 7].x); dst[q] = o; } }
            { LAS bf16* dst = Wst + d * 64 * PQ + c;
#pragma unroll
                for (int i = 0; i < 64; ++i) dst[i * PQ] = (bf16)f2bf(X2[i].y); }
        }
        LDS_BARRIER();
        for (int idx = tid; idx < 2 * 64 * 16; idx += NTHR) {
            const int d = idx >> 10, i = (idx >> 4) & 63, ch = idx & 15, mi = d ? 63 - i : i;
            const size_t rec = ((size_t)((b * 4 + h) * 2 + d)) * 68 + jj;
            *(v4u*)(gb.W + rec * 8192 + i * 128 + 8 * ch) = *(const LAS v4u*)(Wst + (d * 64 + i) * PQ + 8 * ch);
            const v4u qv = *(const LAS v4u*)(Qs + mi * PQ + 8 * ch); const float eg = __expf(sg[d * 64 + i]);
            v4u o; o.x = pk2(bflo(qv.x) * eg, bfhi(qv.x) * eg); o.y = pk2(bflo(qv.y) * eg, bfhi(qv.y) * eg); o.z = pk2(bflo(qv.z) * eg, bfhi(qv.z) * eg); o.w = pk2(bflo(qv.w) * eg, bfhi(qv.w) * eg);
            *(v4u*)(gb.Qd + rec * 8192 + i * 128 + 8 * ch) = o;
        }
        for (int idx = tid; idx < 2 * 8 * 128; idx += NTHR) {
            const int d = idx >> 10, ic = (idx >> 7) & 7, dk = idx & 127;
            const size_t rec = ((size_t)((b * 4 + h) * 2 + d)) * 68 + jj; const float gl = sg[d * 64 + 63];
            float v[8];
#pragma unroll
            for (int e = 0; e < 8; ++e) { const int i = 8 * ic + e, mi = d ? 63 - i : i; v[e] = bf2f(Ks[mi * PQ + dk]) * __expf(gl - sg[d * 64 + i]); }
            v4u o; o.x = pk2(v[0], v[1]); o.y = pk2(v[2], v[3]); o.z = pk2(v[4], v[5]); o.w = pk2(v[6], v[7]);
            *(v4u*)(gb.KdT + rec * 8192 + dk * 64 + 8 * ic) = o;
        }
    }
}

__device__ __forceinline__ void ph_gdn_seq(CP p, LAS unsigned char* lds, int first_block, int nblocks) {
    const int tid = tid_fresh(), lane = tid & 63, w = __builtin_amdgcn_readfirstlane(tid >> 6), r16 = lane & 15, q4 = lane >> 4;
    LAS bf16* Ws = (LAS bf16*)lds;
    LAS bf16* Qds = Ws + 64 * PQ;
    LAS bf16* Kds = Qds + 64 * PQ;
    LAS bf16* QKs = Kds + 128 * PS;
    LAS bf16* VnT = QKs + 64 * PS;
    LAS bf16* St = VnT + 32 * PS;
    const GdnBufs gb = gdn_bufs(p); bf16* og = (bf16*)p.scr1;
    const int bx0 = bid_fresh();
    for (int item = bx0 >= first_block ? bx0 - first_block : 128; item < 128; item += nblocks) {
        const int sl = item & 3, d = (item >> 2) & 1, h = (item >> 3) & 3, b = item >> 5;
        const size_t rec0 = ((size_t)((b * 4 + h) * 2 + d)) * 68;
        f32x4 S[2] = {(f32x4){0.f, 0.f, 0.f, 0.f}, (f32x4){0.f, 0.f, 0.f, 0.f}};
        asm volatile("" : "+v"(S[0]), "+v"(S[1]));
        const int it = w >> 1, vt = w & 1;
        v4u A_rw[2], A_rqd[2], A_rkd[2], A_rqk, B_rw[2], B_rqd[2], B_rkd[2], B_rqk; v2u A_ru, B_ru; float A_rcd, B_rcd;
#define GDN_LOAD(jj, X) do { const unsigned rec_ = (unsigned)rec0 + (unsigned)(jj); \
            _Pragma("unroll") for (int u = 0; u < 2; ++u) { const int ci = tid + 512 * u; X##rw[u] = *(const v4u*)(gb.W + (rec_ * 8192u + (unsigned)ci * 8u)); X##rqd[u] = *(const v4u*)(gb.Qd + (rec_ * 8192u + (unsigned)ci * 8u)); X##rkd[u] = *(const v4u*)(gb.KdT + (rec_ * 8192u + (unsigned)ci * 8u)); } \
            X##rqk = *(const v4u*)(gb.QKm + (rec_ * 4096u + (unsigned)tid * 8u)); \
            X##ru = *(const v2u*)(gb.UT + (rec_ * 8192u + (unsigned)((sl * 32 + 16 * vt + r16) * 64 + 16 * it + 4 * q4))); X##rcd = gb.cd[rec_]; } while (0)
        GDN_LOAD(chunk_of_step(0, d), A_); GDN_LOAD(chunk_of_step(1, d), B_);
#define GDN_STEP(j, X, Y) do { \
            const int jj = chunk_of_step(j, d); \
            LDS_BARRIER(); \
_Pragma("unroll") \
            for (int u = 0; u < 2; ++u) { const int ci = tid + 512 * u; \
                *(LAS v4u*)(Ws + (ci >> 4) * PQ + (ci & 15) * 8) = X##rw[u]; *(LAS v4u*)(Qds + (ci >> 4) * PQ + (ci & 15) * 8) = X##rqd[u]; *(LAS v4u*)(Kds + (ci >> 3) * PS + (ci & 7) * 8) = X##rkd[u]; } \
            *(LAS v4u*)(QKs + (tid >> 3) * PS + (tid & 7) * 8) = X##rqk; \
_Pragma("unroll") \
            for (int n = 0; n < 2; ++n) { v2u o; o.x = pk2(S[n][0], S[n][1]); o.y = pk2(S[n][2], S[n][3]); *(LAS v2u*)(St + (16 * n + r16) * PQ + 16 * w + 4 * q4) = o; } \
            const v2u uu = X##ru; const float cd = X##rcd; \
            LDS_BARRIER(); \
            if (j + 2 < 68) GDN_LOAD(chunk_of_step(j + 2, d), X); \
            f32x4 ws = {0.f, 0.f, 0.f, 0.f}, oo = {0.f, 0.f, 0.f, 0.f}; \
_Pragma("unroll") \
            for (int ks = 0; ks < 4; ++ks) { const bf16x8 sfr = ldfrag(St, PQ, 16 * vt, 32 * ks, lane); \
                ws = MFMA16(ldfrag(Ws, PQ, 16 * it, 32 * ks, lane), sfr, ws); \
                oo = MFMA16(sfr, ldfrag(Qds, PQ, 16 * it, 32 * ks, lane), oo); } \
            { v2u o; o.x = pk2(bflo(uu.x) - ws[0], bfhi(uu.x) - ws[1]); o.y = pk2(bflo(uu.y) - ws[2], bfhi(uu.y) - ws[3]); *(LAS v2u*)(VnT + (16 * vt + r16) * PS + 16 * it + 4 * q4) = o; } \
            LDS_BARRIER(); \
_Pragma("unroll") \
            for (int ks = 0; ks < 2; ++ks) oo = MFMA16(ldfrag(VnT, PS, 16 * vt, 32 * ks, lane), ldfrag(QKs, PS, 16 * it, 32 * ks, lane), oo); \
            { const int i = 16 * it + r16, mi = d ? 63 - i : i; \
              v2u ob; ob.x = pk2(oo[0], oo[1]); ob.y = pk2(oo[2], oo[3]); *(v2u*)(og + ((size_t)d * T + b * TPB + 64 * jj + mi) * 512 + h * 128 + sl * 32 + 16 * vt + 4 * q4) = ob; } \
_Pragma("unroll") \
            for (int n = 0; n < 2; ++n) S[n] = S[n] * cd; \
_Pragma("unroll") \
            for (int ks = 0; ks < 2; ++ks) { const bf16x8 a = ldfrag(Kds, PS, 16 * w, 32 * ks, lane); \
_Pragma("unroll") \
                for (int n = 0; n < 2; ++n) S[n] = MFMA16(a, ldfrag(VnT, PS, 16 * n, 32 * ks, lane), S[n]); } \
} while (0)
        for (int j = 0; j < 68; j += 2) { GDN_STEP(j, A_, B_); GDN_STEP(j + 1, B_, A_); }
#undef GDN_LOAD
    }
}

__device__ __forceinline__ void ph_merge_even(CP p) {
    const int tid = tid_fresh(), wv = tid >> 6, which = wv >> 2, h = wv & 3, lane = tid & 63;
    const bf16* o_f = (const bf16*)p.scr1 + (size_t)which * 2 * T * 512 + h * 128 + 2 * lane; const bf16* o_b = o_f + (size_t)T * 512;
    const bf16* gate = p.P + (which ? C_MO : C_Z) + h * 128 + 2 * lane;
    const float2 gain = *(const float2*)((which ? p.ml_norm_g + h * 128 : p.gdn_norm_g) + 2 * lane);
    bf16* outp = p.merged + which * 512 + h * 128 + 2 * lane;
    for (int t0 = blockIdx.x * 4; t0 < T; t0 += gridDim.x * 4) {
        unsigned vf[4], vb[4], vg[4];
#pragma unroll
        for (int u = 0; u < 4; ++u) { const size_t t = t0 + u; vf[u] = *(const unsigned*)(o_f + t * 512); vb[u] = *(const unsigned*)(o_b + t * 512); vg[u] = *(const unsigned*)(gate + t * LDP0); }
#pragma unroll
        for (int u = 0; u < 4; ++u) {
            const float a = bflo(vf[u]) + bflo(vb[u]), b = bfhi(vf[u]) + bfhi(vb[u]);
            const float rs = rsqrtf(wave_sum(a * a + b * b) * (1.f / 128.f) + EPS);
            const float g0 = bflo(vg[u]), g1 = bfhi(vg[u]);
            const float m0 = which ? sigmoidf_(g0) : siluf_(g0), m1 = which ? sigmoidf_(g1) : siluf_(g1);
            *(unsigned*)(outp + (size_t)(t0 + u) * D) = pk2(a * rs * gain.x * m0, b * rs * gain.y * m1);
        }
    }
}
constexpr int RA_P = 1032;
__device__ __forceinline__ void ph_norm2_router(CP p, LAS unsigned char* lds, int layer, int dummy = 0) {
    const int tid = tid_fresh(), lane = tid & 63, w = __builtin_amdgcn_readfirstlane(tid >> 6), r16 = lane & 15, q4 = lane >> 4;
    LAS bf16* Ah = (LAS bf16*)lds; LAS bf16* Al = Ah + 16 * RA_P; LAS float* part = (LAS float*)(Al + 16 * RA_P);
    LAS int* lcnt = (LAS int*)(lds + 131072 + 1024);
    if (tid < 64) lcnt[tid] = 0;
    bf16x8 bh[2][4], bl[2][4];
#pragma unroll
    for (int n = 0; n < 2; ++n)
#pragma unroll
        for (int ks = 0; ks < 4; ++ks) { const size_t o = ((size_t)layer * NE + 16 * n + r16) * D + 128 * w + 32 * ks + 8 * q4; bh[n][ks] = *(const bf16x8*)(p.rwh + o); bl[n][ks] = *(const bf16x8*)(p.rwl + o); }
    __syncthreads();
    const float* g = p.norm2_g + layer * D;
    const float* modl = p.mod + (size_t)layer * 5 * 6 * D + 3 * D;
    const float rbias = p.router_b[layer * NE + (lane >> 1)];
    int* cnt = (int*)p.ctl + (layer * NE) * 64 + dummy * 4096; int* asg_e = dummy ? (int*)p.scr2 : p.asg_e; int* asg_pos = dummy ? (int*)p.scr2 + T * 4 : p.asg_pos; float* asg_w = dummy ? p.scr2 + T * 8 : p.asg_w;
    const int NGRP = (layer ? NB * SEQ : T) / 16;
    v2u xn[2][4];
#define RT_TOK(gi_, u_) (layer ? (((gi_) * 16 + 2 * w + (u_)) >> 12) * TPB + CTX + (((gi_) * 16 + 2 * w + (u_)) & 4095) : (gi_) * 16 + 2 * w + (u_))
#define RT_LOAD(gi_) do { _Pragma("unroll") for (int u = 0; u < 2; ++u) { const v2u* x4_ = (const v2u*)((const bf16*)p.xres + (size_t)RT_TOK(gi_, u) * D) + lane; \
        _Pragma("unroll") for (int j = 0; j < 4; ++j) xn[u][j] = x4_[64 * j]; } } while (0)
    if ((int)blockIdx.x < NGRP) RT_LOAD((int)blockIdx.x);
    for (int gi = blockIdx.x; gi < NGRP; gi += gridDim.x) {
        int tt[2]; v2u xc[2][4];
#pragma unroll
        for (int u = 0; u < 2; ++u)
#pragma unroll
            for (int j = 0; j < 4; ++j) xc[u][j] = xn[u][j];
#pragma unroll
        for (int u = 0; u < 2; ++u) {
            const int tl = 2 * w + u, t = RT_TOK(gi, u); tt[u] = t;
            const int r = (t % TPB) < CTX ? 4 : t / TPB;
            const f32x4* g4 = (const f32x4*)g + lane; const f32x4* sh4 = (const f32x4*)(modl + (size_t)r * 6 * D) + lane; const f32x4* sc4 = sh4 + D / 4;
            f32x4 v[4]; float s = 0.f;
#pragma unroll
            for (int j = 0; j < 4; ++j) { const v2u xb = xc[u][j]; v[j] = (f32x4){bflo(xb.x), bfhi(xb.x), bflo(xb.y), bfhi(xb.y)}; s += (v[j].x * v[j].x + v[j].y * v[j].y) + (v[j].z * v[j].z + v[j].w * v[j].w); }
            const float rs = rsqrtf(wave_sum(s) * (1.f / D) + EPS);
#pragma unroll
            for (int j = 0; j < 4; ++j) { const f32x4 gg = g4[64 * j], sh = sh4[64 * j], sc = sc4[64 * j];
                f32x4 h; h.x = (v[j].x * rs * gg.x) * (1.f + sc.x) + sh.x; h.y = (v[j].y * rs * gg.y) * (1.f + sc.y) + sh.y; h.z = (v[j].z * rs * gg.z) * (1.f + sc.z) + sh.z; h.w = (v[j].w * rs * gg.w) * (1.f + sc.w) + sh.w;
                v2u hi; hi.x = pk2(h.x, h.y); hi.y = pk2(h.z, h.w);
                v2u lo; lo.x = pk2(h.x - bflo(hi.x), h.y - bfhi(hi.x)); lo.y = pk2(h.z - bflo(hi.y), h.w - bfhi(hi.y));
                *(LAS v2u*)(Ah + tl * RA_P + 4 * lane + 256 * j) = hi; *(LAS v2u*)(Al + tl * RA_P + 4 * lane + 256 * j) = lo;
                *(unsigned*)(p.h8 + (size_t)t * D + 4 * lane + 256 * j) = pk4_f8(h.x, h.y, h.z, h.w); }
        }
        if (gi + (int)gridDim.x < NGRP) RT_LOAD(gi + (int)gridDim.x);
        LDS_BARRIER();
        {
            f32x4 acc[2] = {(f32x4){0.f, 0.f, 0.f, 0.f}, (f32x4){0.f, 0.f, 0.f, 0.f}};
#pragma unroll
            for (int ks = 0; ks < 4; ++ks) { const bf16x8 ah = ldfrag(Ah, RA_P, 0, 128 * w + 32 * ks, lane), al = ldfrag(Al, RA_P, 0, 128 * w + 32 * ks, lane);
#pragma unroll
                for (int n = 0; n < 2; ++n) { acc[n] = MFMA16(ah, bh[n][ks], acc[n]); acc[n] = MFMA16(ah, bl[n][ks], acc[n]); acc[n] = MFMA16(al, bh[n][ks], acc[n]); } }
#pragma unroll
            for (int n = 0; n < 2; ++n)
#pragma unroll
                for (int i = 0; i < 4; ++i) part[(w * 16 + 4 * q4 + i) * 33 + 16 * n + r16] = acc[n][i];
        }
        LDS_BARRIER();
        int ln = lane; asm volatile("" : "+v"(ln));
#pragma unroll
        for (int u = 0; u < 2; ++u) {
            const int tl = 2 * w + u, t = tt[u], myidx = ln >> 1;
            float lg = rbias;
#pragma unroll
            for (int ww = 0; ww < 8; ++ww) lg += part[(ww * 16 + tl) * 33 + myidx];
            float tv[4]; int ti[4];
#pragma unroll
            for (int k = 0; k < 4; ++k) {
                float bv = lg; int bi = myidx;
#pragma unroll
                for (int off = 1; off < 64; off <<= 1) { const float ov = shflx(bv, off, ln); const int oi = shflxi(bi, off, ln); const bool take = (ov > bv) || (ov == bv && oi < bi); bv = take ? ov : bv; bi = take ? oi : bi; }
                tv[k] = bv; ti[k] = bi; if (myidx == bi) lg = -INFINITY;
            }
            float ex[4], den = 0.f;
#pragma unroll
            for (int k = 0; k < 4; ++k) { ex[k] = __expf(tv[k] - tv[0]); den += ex[k]; }
            if (lane < 4) {
                int e = ti[0]; float wgt = ex[0];
#pragma unroll
                for (int k = 1; k < 4; ++k) if (lane == k) { e = ti[k]; wgt = ex[k]; }
                const int pos = __hip_atomic_fetch_add(&lcnt[e], 1, __ATOMIC_RELAXED, __HIP_MEMORY_SCOPE_WORKGROUP);
                asg_e[t * 4 + lane] = e; asg_pos[t * 4 + lane] = pos; asg_w[t * 4 + lane] = wgt * __builtin_amdgcn_rcpf(den);
            }
        }
    }
#undef RT_LOAD
    __syncthreads();
    if (tid < NE) lcnt[NE + tid] = atomicAdd(&cnt[tid * 64], lcnt[tid]);
    __syncthreads();
    unsigned char* hs8 = dummy ? (unsigned char*)p.scr1 : (unsigned char*)p.hs;
    for (int gi = blockIdx.x; gi < NGRP; gi += gridDim.x) {
#pragma unroll
        for (int u = 0; u < 2; ++u) { const int qq = gi * 16 + 2 * w + u, t = layer ? (qq >> 12) * TPB + CTX + (qq & 4095) : qq;
            int e = 0, pos = 0;
            if (lane < 4) { e = asg_e[t * 4 + lane]; pos = asg_pos[t * 4 + lane] + lcnt[NE + e]; asg_pos[t * 4 + lane] = pos; }
            const unsigned long long* src = (const unsigned long long*)(p.h8 + (size_t)t * D) + 2 * lane;
            const unsigned long long v0 = __hip_atomic_load(src, __ATOMIC_RELAXED, __HIP_MEMORY_SCOPE_AGENT), v1 = __hip_atomic_load(src + 1, __ATOMIC_RELAXED, __HIP_MEMORY_SCOPE_AGENT);
#pragma unroll
            for (int k = 0; k < 4; ++k) { const int ek = __shfl(e, k), pk = __shfl(pos, k);
                unsigned long long* dst = (unsigned long long*)(hs8 + ((size_t)ek * T + pk) * D) + 2 * lane; dst[0] = v0; dst[1] = v1; } }
    }
}
__device__ __forceinline__ void moe_base_to_lds(CP p, int layer, int* base_gen) {
    if (tid_fresh() == 0) { const int* cnt = (const int*)p.ctl + (layer * NE) * 64; int a = 0; for (int e = 0; e < NE; ++e) { base_gen[e] = a; const int ce = __hip_atomic_load(cnt + e * 64, __ATOMIC_RELAXED, __HIP_MEMORY_SCOPE_AGENT); base_gen[40 + e] = ce; a += (ce + 255) / 256 * 256; } base_gen[NE] = a; }
    __syncthreads();
    { const int rb = tid_fresh(); if (rb < MOE_ROWS / 256) { int e = 0; for (int k = 1; k < NE; ++k) e = ((rb << 8) >= base_gen[k]) ? k : e; ((unsigned char*)base_gen)[320 + rb] = (unsigned char)e; } }
    __syncthreads();
}
__device__ __forceinline__ void ph_combine(CP p, int layer, const int* base, int dummy = 0) {
    const int tid_ = tid_fresh(), lane = tid_ & 63, gw = blockIdx.x * NWAVES + (tid_ >> 6), NGW = gridDim.x * NWAVES;
    const float* modl = p.mod + (size_t)layer * 5 * 6 * D;
    const int NTOK = layer ? NB * SEQ : T;
    int ne_[2][4], np_[2][4]; float nw_[2][4];
#define CMB_TOK(q) (layer ? ((q) >> 12) * TPB + CTX + ((q) & 4095) : (q))
#define CMB_LOAD_ASG(q0_) do { _Pragma("unroll") for (int u = 0; u < 2; ++u) { const int q = (q0_) + u * NGW; const int qq = q < NTOK ? q : (q0_); const int t_ = CMB_TOK(qq); \
        _Pragma("unroll") for (int k = 0; k < 4; ++k) { ne_[u][k] = p.asg_e[t_ * 4 + k]; np_[u][k] = p.asg_pos[t_ * 4 + k]; nw_[u][k] = p.asg_w[t_ * 4 + k]; } } } while (0)
    if (gw < NTOK) CMB_LOAD_ASG(gw);
    for (int q0 = gw; q0 < NTOK; q0 += 2 * NGW) {
        int tt[2], rr[2]; bool ok[2]; int rows[2][4]; float w[2][4];
#pragma unroll
        for (int u = 0; u < 2; ++u) { const int q = q0 + u * NGW; ok[u] = q < NTOK; const int qq = ok[u] ? q : q0; tt[u] = CMB_TOK(qq); rr[u] = (tt[u] % TPB) < CTX ? 4 : tt[u] / TPB;
#pragma unroll
            for (int k = 0; k < 4; ++k) { rows[u][k] = base[ne_[u][k]] + np_[u][k]; w[u][k] = nw_[u][k]; } }
        if (q0 + 2 * NGW < NTOK) CMB_LOAD_ASG(q0 + 2 * NGW);
        f32x4 v[2][4], G[2][4], SH[2][4]; float s[2] = {0.f, 0.f};
#pragma unroll
        for (int u = 0; u < 2; ++u) {
            const v2u* x4 = (const v2u*)((const bf16*)p.xres + (size_t)tt[u] * D) + lane; const f32x4* g24 = (const f32x4*)(modl + (size_t)rr[u] * 6 * D + 5 * D) + lane;
            const f32x4* g4 = (layer == 0 ? (const f32x4*)(p.norm1_g + D) : (const f32x4*)p.final_g) + lane;
            const f32x4* sh4 = (const f32x4*)(p.mod + (size_t)5 * 6 * D + (size_t)rr[u] * 6 * D) + lane; const f32x4* sc4 = sh4 + D / 4;
#pragma unroll
            for (int j = 0; j < 4; ++j) {
                f32x4 acc = {0.f, 0.f, 0.f, 0.f};
                G[u][j] = g4[64 * j]; if (layer == 0) { SH[u][j] = sh4[64 * j]; G[u][j] = G[u][j] * (sc4[64 * j] + 1.f); }
#pragma unroll
                for (int k = 0; k < 4; ++k) { const v2u yv = *((const v2u*)(p.yb + (size_t)rows[u][k] * D) + lane + 64 * j);
                    acc.x += w[u][k] * bflo(yv.x); acc.y += w[u][k] * bfhi(yv.x); acc.z += w[u][k] * bflo(yv.y); acc.w += w[u][k] * bfhi(yv.y); }
                { const v2u xb = x4[64 * j]; v[u][j] = (f32x4){bflo(xb.x), bfhi(xb.x), bflo(xb.y), bfhi(xb.y)} + g24[64 * j] * acc; }
                s[u] += (v[u][j].x * v[u][j].x + v[u][j].y * v[u][j].y) + (v[u][j].z * v[u][j].z + v[u][j].w * v[u][j].w);
            }
        }
#pragma unroll
        for (int u = 0; u < 2; ++u) {
            if (!ok[u]) continue;
            const int t = tt[u];
            const float rs = rsqrtf(wave_sum(s[u]) * (1.f / D) + EPS);
            if (layer == 0) {
#pragma unroll
                for (int j = 0; j < 4; ++j) { { v2u xo; xo.x = pk2(v[u][j].x, v[u][j].y); xo.y = pk2(v[u][j].z, v[u][j].w); *((v2u*)((bf16*)(dummy ? p.scr0 : p.xres) + (size_t)t * D) + lane + 64 * j) = xo; }
                    const f32x4 gg = G[u][j], sh = SH[u][j];
                    v2u o; o.x = pk2((v[u][j].x * rs) * gg.x + sh.x, (v[u][j].y * rs) * gg.y + sh.y); o.y = pk2((v[u][j].z * rs) * gg.z + sh.z, (v[u][j].w * rs) * gg.w + sh.w);
                    *((v2u*)((dummy ? (bf16*)p.scr1 : p.hb) + (size_t)t * D) + lane + 64 * j) = o; }
            } else {
                float* orow = (dummy ? p.scr0 : p.out) + ((size_t)(t / TPB) * SEQ + (t % TPB - CTX)) * D;
#pragma unroll
                for (int j = 0; j < 4; ++j) { const f32x4 gg = G[u][j]; f32x4 o; o.x = v[u][j].x * rs * gg.x; o.y = v[u][j].y * rs * gg.y; o.z = v[u][j].z * rs * gg.z; o.w = v[u][j].w * rs * gg.w; *((f32x4*)orow + lane + 64 * j) = o; }
            }
        }
    }
#undef CMB_TOK
#undef CMB_LOAD_ASG
}

#ifndef REP_PRO
#define REP_PRO 1
#endif
#ifndef REP_GEMM
#define REP_GEMM 1
#endif
#ifndef REP_GDNL
#define REP_GDNL 1
#endif
#ifndef REP_SEQ
#define REP_SEQ 1
#endif
#ifndef REP_ROUTER
#define REP_ROUTER 1
#endif
#ifndef REP_COMB
#define REP_COMB 1
#endif
#ifndef REP_OUT0
#define REP_OUT0 1
#endif
#ifndef REP_GSEQ
#define REP_GSEQ 0
#endif
#ifndef REP_MSEQ
#define REP_MSEQ 0
#endif
#ifndef REP_THIN
#define REP_THIN 1
#endif
#ifndef REP_RET
#define REP_RET 1
#endif
#define REPEAT_0(X)
#define REPEAT_1(X) X
#define REPEAT_2(X) X X
#define REPEAT_N_(n, X) REPEAT_##n(X)
#define REPEAT_N(n, X) REPEAT_N_(n, X)
#define REPEAT_PRO(X) REPEAT_N(REP_PRO, X)
#define REPEAT_GEMM(X) REPEAT_N(REP_GEMM, X)
#define REPEAT_SCAN(X) REPEAT_N(REP_SCAN, X)
constexpr int CTL_BYTES = 65536, BAR_WORD0 = 12288, LDS_MISC = 131072, LDS_BASE = 131072 + 256;
__global__ void __launch_bounds__(NTHR, 2) k_mega(Params p) {
    extern __shared__ __attribute__((aligned(16))) unsigned char lds_raw[];
    LAS unsigned char* lds = (LAS unsigned char*)lds_raw;
    volatile LAS unsigned* misc = (volatile LAS unsigned*)(lds + LDS_MISC);
    if (threadIdx.x < 64) misc[threadIdx.x] = 0u;
    if ((threadIdx.x & 63) == 0) *(volatile LAS int*)(lds + LDS_WAVETAB + 4 * ((unsigned)__builtin_amdgcn_s_getreg((5 << 11) | 4) & 63u)) = (int)(threadIdx.x >> 6);
    __syncthreads();
    (void)xcd_barrier_post((unsigned*)kp_fresh()->ctl + BAR_WORD0, misc);
    int* base_gen = (int*)(lds_raw + LDS_BASE);
#define GRID_BAR() do { XcdBarrier bb; bb.bar = (unsigned*)kp_fresh()->ctl + BAR_WORD0; bb.x = xb_xcc_id(); bb.st = misc; xcd_barrier(bb); } while (0)

#define PH(stmt) do { CP P = *kp_fresh(); stmt; } while (0)
#if defined(REP_BAR)
    for (int rb_ = 0; rb_ < REP_BAR; ++rb_) GRID_BAR();
#endif
    REPEAT_PRO(PH(ph_prologue(P, lds)); GRID_BAR();)
    REPEAT_N(REP_THIN, PH(ph_norm(P, 0, 0)); GRID_BAR();)
#pragma unroll
    for (int layer = 0; layer < 2; ++layer) {
        REPEAT_GEMM(PH(ph_gemm_in(P, lds, layer)); GRID_BAR();)
        if (layer == 0) {
            REPEAT_N(REP_GDNL, PH(ph_gdn_local(P, lds); __syncthreads(); ph_fill(P, lds, FILL_LOCAL)); GRID_BAR();)
            REPEAT_N(REP_SEQ, { const int half = gridDim.x >> 1; PH(ph_gdn_seq(P, lds, 0, half); if ((int)blockIdx.x < half) { __syncthreads(); ph_fill(P, lds, FILL_SEQ); } REPEAT_N(REP_GSEQ, ph_gdn_seq(P, lds, 0, half);) ph_mlstm_scan(P, lds, half, gridDim.x - half); REPEAT_N(REP_MSEQ, ph_mlstm_scan(P, lds, half, gridDim.x - half);) if ((int)blockIdx.x >= half) { __syncthreads(); ph_fill(P, lds, FILL_SEQ); }); GRID_BAR(); })
            REPEAT_N(REP_THIN, PH(ph_merge_even(P)); GRID_BAR();)
        } else {
            REPEAT_N(REP_RET, PH(ph_ret_scan(P, lds)); GRID_BAR();)
            REPEAT_N(REP_THIN, PH(ph_merge_odd(P)); GRID_BAR();)
        }
        PH(ph_gemm_out(P, lds, layer)); GRID_BAR();
#if REP_OUT0 == 2
        if (layer == 0) { PH(ph_gemm_out(P, lds, layer)); GRID_BAR(); }
#endif
        PH(ph_norm2_router(P, lds, layer); if (layer == 1) { __syncthreads(); ph_fill(P, lds, FILL_CATCH); }); GRID_BAR();
#if REP_ROUTER == 2
        PH(ph_norm2_router(P, lds, layer, 1)); GRID_BAR();
#endif
        PH(moe_base_to_lds(P, layer, base_gen));
        REPEAT_GEMM(PH(ph_moe_gu(P, lds, layer, base_gen)); GRID_BAR();)
        REPEAT_GEMM(PH(ph_moe_dn(P, lds, layer, base_gen)); GRID_BAR();)
#if REP_COMB == 2
        PH(ph_combine(P, layer, base_gen, 1)); GRID_BAR();
#endif
        PH(ph_combine(P, layer, base_gen));
        if (layer == 0) GRID_BAR();
    }
}

extern "C" void kernel_launch(void* const* d_in, const int* in_sizes, int n_in, void* d_out, int out_size, void* d_ws, size_t ws_size, hipStream_t stream) {
    Params p{};
    const float** pin = (const float**)&p;
    for (int i = 0; i < 27; ++i) pin[i] = (const float*)d_in[i];
    p.out = (float*)d_out;
    char* ws = (char*)d_ws; size_t off = 0;
    auto take = [&](size_t bytes) { char* q = ws + off; off += (bytes + 255) & ~(size_t)255; return q; };
    p.ctl = (unsigned*)take(CTL_BYTES);
    p.mod = (float*)take((size_t)2 * 5 * 6 * D * 4);
    p.xres = (float*)take((size_t)T * D * 4);
    p.rope = (float*)take((size_t)TPB * 64 * 2 * 4);
    p.od = (bf16*)take((size_t)2 * T * 2048 * 2);
    p.hb = (bf16*)take((size_t)T * D * 2);
    p.P = (bf16*)take((size_t)T * LDP1 * 2);
    p.merged = (bf16*)take((size_t)T * 2048 * 2);
    p.wt_in0 = (bf16*)take((size_t)LDP0 * D * 2); p.wt_out0 = (bf16*)take((size_t)D * D * 2); p.wt_in1 = (bf16*)take((size_t)LDP1 * D * 2); p.wt_out1 = (bf16*)take((size_t)D * 2 * D * 2);
    p.wt_gu = (bf16*)take((size_t)2 * NE * 2 * DFF * D); p.wt_dn = (bf16*)take((size_t)2 * NE * D * DFF);
    p.act = (bf16*)take((size_t)MOE_ROWS * DFF);     p.yb = (bf16*)take((size_t)MOE_ROWS * D * 2);
    p.asg_e = (int*)take((size_t)T * 4 * 4); p.asg_pos = (int*)take((size_t)T * 4 * 4); p.slot_tok = (int*)take((size_t)NE * T * 4); p.h8 = (unsigned char*)take((size_t)T * D); p.rwh = (bf16*)take((size_t)2 * NE * D * 2); p.rwl = (bf16*)take((size_t)2 * NE * D * 2); p.asg_w = (float*)take((size_t)T * 4 * 4);
    p.scr0 = (float*)take((size_t)NE * T * D);
    p.hs = (bf16*)p.scr0;
    p.scr1 = (float*)take((size_t)3 * T * 1024 * 4);
    p.scr2 = (float*)take((size_t)8 * T * 4 * 4);
    static int grid = 0;
    if (!grid) {
        int dev = 0, cus = 0, per_cu = 0;
        if (off > ws_size || n_in != 27) { fprintf(stderr, "kernel_launch: workspace too small or bad inputs: need %zu, have %zu, n_in %d\n", off, ws_size, n_in); grid = -1; }
        else if (hipGetDevice(&dev) != hipSuccess || hipDeviceGetAttribute(&cus, hipDeviceAttributeMultiprocessorCount, dev) != hipSuccess) grid = -1;
        else if (hipFuncSetAttribute((const void*)k_mega, hipFuncAttributeMaxDynamicSharedMemorySize, LDS_BYTES) != hipSuccess) grid = -1;
        else { if (hipOccupancyMaxActiveBlocksPerMultiprocessor(&per_cu, (const void*)k_mega, NTHR, LDS_BYTES) != hipSuccess || per_cu < 1) fprintf(stderr, "kernel_launch: occupancy query says %d blocks per CU\n", per_cu);
               grid = cus; }
        if (grid < 0) fprintf(stderr, "kernel_launch: set-up failed; nothing launched\n");
    }
    if (grid <= 0) return;
    (void)hipMemsetAsync(p.ctl, 0, CTL_BYTES, stream);
    hipLaunchKernelGGL(k_mega, dim3(grid), dim3(NTHR), LDS_BYTES, stream, p);
}
```

```cpp
#include <hip/hip_runtime.h>
#include <cstdio>
#include <cstdint>
constexpr int LDS_WAVETAB = 131072 + 2048;
__device__ __forceinline__ int tid_fresh() {
    extern __shared__ __attribute__((aligned(16))) unsigned char lds_raw_t[];
    int z; asm volatile("v_mov_b32 %0, 0" : "=v"(z));
    const int lane = (int)__builtin_amdgcn_mbcnt_hi(~0u, __builtin_amdgcn_mbcnt_lo(~0u, (unsigned)z));
    const unsigned hw = (unsigned)__builtin_amdgcn_s_getreg((5 << 11) | 4) & 63u;
    const int wv = __builtin_amdgcn_readfirstlane(*(volatile __attribute__((address_space(3))) int*)((__attribute__((address_space(3))) unsigned char*)lds_raw_t + LDS_WAVETAB + 4 * hw));
    int t = wv * 64 + lane; asm volatile("" : "+v"(t)); return t;
}
namespace pg8 {
#define PG8_LAS __attribute__((address_space(3)))
typedef unsigned short bf16_t;
typedef short bf16x8 __attribute__((ext_vector_type(8)));
typedef float f32x4 __attribute__((ext_vector_type(4)));
typedef unsigned u32x4 __attribute__((ext_vector_type(4)));
constexpr int BM = 256, BK = 64, HALF = 128, HTB = HALF * BK * 2  , STAGE_BYTES = 8 * HTB, NXCD = 8, WGM = 8;

__host__ __device__ __forceinline__ int lds_byte(int r, int c) { const int st = (r >> 4) * 2 + (c >> 5), rr = r & 15, cc = c & 31, ob = rr * 64 + cc * 2; return st * 1024 + (ob ^ (((ob >> 9) & 1) << 5)); }
__host__ __device__ __forceinline__ void stage_rc(int b, int& R, int& C) { const int st = b / 1024, sb = b % 1024, swz = sb ^ (((sb >> 9) & 1) << 5); R = (st >> 1) * 16 + swz / 64; C = (st & 1) * 32 + (swz % 64) / 2; }
__host__ __device__ __forceinline__ int perm32(int rho) { const int n = rho >> 4, i = rho & 15; return 8 * (i >> 2) + 4 * n + (i & 3); }

struct Unit { int pm, pn; };
struct Gemm { const bf16_t* A; const bf16_t* Bt; int M, N, K; };

struct StaticOrder {
    int nM, nN, nwg, G, c;
    __host__ __device__ void init(int M, int N, int G_, int c_) { nM = M / BM; nN = N / BM; nwg = nM * nN; G = G_; c = c_; }
    __host__ __device__ bool next(int i, Unit& u) const {
        const long L = (long)i * G + c; if (L >= nwg) return false;
        int wgid = (int)L; { const int q = nwg / NXCD, r = nwg % NXCD, xcd = wgid % NXCD, off = wgid / NXCD; wgid = (xcd < r ? xcd * (q + 1) : r * (q + 1) + (xcd - r) * q) + off; }
        const int nig = WGM * nN, gid = wgid / nig, fm = gid * WGM, gsz = (nM - fm) < WGM ? (nM - fm) : WGM;
        u.pm = fm + ((wgid % nig) % gsz); u.pn = (wgid % nig) / gsz; return true;
    }
    __device__ __forceinline__ void a_ready(const Unit&) const {}
    __device__ __forceinline__ void done(const Unit&) const {}
};

__device__ __forceinline__ unsigned cvt_pk_bf16(float lo, float hi) { unsigned r; asm volatile("v_cvt_pk_bf16_f32 %0, %1, %2" : "=v"(r) : "v"(lo), "v"(hi)); return r; }
typedef float f32x2 __attribute__((ext_vector_type(2)));
__device__ __forceinline__ f32x2 gelu_pk(f32x2 v) {
    const f32x2 av = __builtin_elementwise_abs(v), d = av * 0.2316418882f + 1.0f;
    f32x2 t; t.x = __builtin_amdgcn_rcpf(d.x); t.y = __builtin_amdgcn_rcpf(d.y);
    f32x2 q = t * 0.5307027145f + (-0.7265760135f); q = q * t + 0.7107068705f; q = q * t + (-0.142248368f); q = q * t + 0.127414796f; q = q * t;
    const f32x2 s = (v * v) * (-0.72134752044f);
    f32x2 e; e.x = __builtin_amdgcn_exp2f(s.x); e.y = __builtin_amdgcn_exp2f(s.y);
    const f32x2 m = v * (q * e), r = v - m;
    f32x2 o; o.x = v.x < 0.f ? m.x : r.x; o.y = v.y < 0.f ? m.y : r.y; return o;
}

template <int ACT  > struct EpiBf16 {
    static constexpr bool PERM = true, AFTER_DRAIN = false, LDS_BIAS = false; static_assert(ACT == 0 || ACT == 1, "EpiBf16: ACT is 0 (none) or 1 (gelu_pk)");
    bf16_t* O; int ldc; const float* bias; int split_cols; size_t split_stride; float scale0;
    __device__ __forceinline__ void operator()(const f32x4 (&acc)[2][2][4][2], const Unit& u, int wr, int wc, int fr, int fq) const {
        const int row0 = u.pm * BM + wr * 64 + fr; int colt = u.pn * BM; bf16_t* base = O;
        float sc = 1.f; if (split_cols) { const int t = colt / split_cols; base += (size_t)t * split_stride; colt -= t * split_cols; if (t == 0) sc = scale0; }
        const int col0 = colt + wc * 32 + 8 * fq, bcol0 = u.pn * BM + wc * 32 + 8 * fq;
        f32x4 bv[2][2];
#pragma unroll
        for (int bj = 0; bj < 2; ++bj)
#pragma unroll
            for (int n = 0; n < 2; ++n) bv[bj][n] = bias ? *(const f32x4*)(bias + bcol0 + bj * HALF + 4 * n) : (f32x4){0.f, 0.f, 0.f, 0.f};
#pragma unroll
        for (int ai = 0; ai < 2; ++ai)
#pragma unroll
            for (int m = 0; m < 4; ++m) { bf16_t* rowp = base + (size_t)(row0 + ai * HALF + m * 16) * ldc + col0;
#pragma unroll
                for (int bj = 0; bj < 2; ++bj) { f32x4 v0 = acc[ai][bj][m][0] + bv[bj][0], v1 = acc[ai][bj][m][1] + bv[bj][1];
                    if (ACT == 1) { f32x2 a = gelu_pk((f32x2){v0[0], v0[1]}), b = gelu_pk((f32x2){v0[2], v0[3]}), c = gelu_pk((f32x2){v1[0], v1[1]}), d = gelu_pk((f32x2){v1[2], v1[3]});
                        v0 = (f32x4){a.x, a.y, b.x, b.y}; v1 = (f32x4){c.x, c.y, d.x, d.y}; }
                    v0 = v0 * sc; v1 = v1 * sc; u32x4 w; w.x = cvt_pk_bf16(v0[0], v0[1]); w.y = cvt_pk_bf16(v0[2], v0[3]); w.z = cvt_pk_bf16(v1[0], v1[1]); w.w = cvt_pk_bf16(v1[2], v1[3]);
                    *(u32x4*)(rowp + bj * HALF) = w; } }
    }
};

template <class Epi, class Sched, bool ALIGN_EPI = false, bool SP2 = false, bool GATHER = false, bool F8 = false>
__device__ __forceinline__ void gemm_phase(PG8_LAS unsigned char* lds, const Gemm g, const Sched& S, const Epi& E) {
    const int tid = tid_fresh(); const int wid = __builtin_amdgcn_readfirstlane(tid >> 6), lane = tid & 63, wr = wid >> 2, wc = wid & 3, fr = lane & 15, fq = lane >> 4;
    typedef int pg8_i32x8 __attribute__((ext_vector_type(8))); typedef int pg8_i32x4 __attribute__((ext_vector_type(4)));
    const int K = g.K, nt = K / BK;
    unsigned voffA[2], voffB[2];
#pragma unroll
    for (int i = 0; i < 2; ++i) { int R, C; stage_rc(tid * 16 + i * 8192, R, C); const int Rb = Epi::PERM ? ((R & ~31) + perm32(R & 31)) : R;
        voffA[i] = (unsigned)(R * K + C) * 2u; voffB[i] = (unsigned)(Rb * K + C) * 2u; }
    unsigned gC[2][2] = {{0u, 0u}, {0u, 0u}}, gN[2][2] = {{0u, 0u}, {0u, 0u}};
    const size_t kstep = (size_t)(BK * 2);
    const size_t hstep = (size_t)HALF * K * 2;
    const size_t tstep = 2 * hstep;
    const unsigned ldsw = (unsigned)wid * 1024u;
    const int aoff = lds_byte(wr * 64 + fr, fq * 8), boff = lds_byte(wc * 32 + fr, fq * 8);
#define PG8_SA(b, h) (((b) * 2 + (h)) * HTB)
#define PG8_SB(b, h) ((4 + (b) * 2 + (h)) * HTB)
#define PG8_STAGE(bufoff, gbase, voff) do { _Pragma("unroll") for (int _i = 0; _i < 2; ++_i) \
        __builtin_amdgcn_global_load_lds((const unsigned*)((const char*)(gbase) + (voff)[_i]), (PG8_LAS unsigned*)(lds + (bufoff) + ldsw + _i * 8192), 16, 0, 0); } while (0)
#define PG8_GOFF(dst, u) do { if constexpr (GATHER) { _Pragma("unroll") for (int _i = 0; _i < 2; ++_i) _Pragma("unroll") for (int _h = 0; _h < 2; ++_h) { int _R, _C; stage_rc(tid * 16 + _i * 8192, _R, _C); dst[_h][_i] = S.a_off(u, _h * HALF + _R) + (unsigned)(_C * 2); asm volatile("" : "+v"(dst[_h][_i]) :: "memory"); } } } while (0)
#define PG8_STAGE_A(bufoff, kofs, half, nx) do { if constexpr (GATHER) { const char* _b = (const char*)g.A + (kofs); _Pragma("unroll") for (int _i = 0; _i < 2; ++_i) { const unsigned _o = (nx) ? gN[half][_i] : gC[half][_i]; \
            __builtin_amdgcn_global_load_lds((const unsigned*)(_b + _o), (PG8_LAS unsigned*)(lds + (bufoff) + ldsw + _i * 8192), 16, 0, 0); } } \
        else { const char* _b = ((nx) ? nA : cA) + (kofs) + (half) * hstep; PG8_STAGE(bufoff, _b, voffA); } } while (0)
#define PG8_LD16(off) (*(const PG8_LAS pg8_i32x4*)(lds + (off)))
#define PG8_LDA(dst, b, h) do { if constexpr (F8) { _Pragma("unroll") for (int m = 0; m < 4; ++m) dst##8[m] = __builtin_shufflevector(PG8_LD16(PG8_SA(b, h) + aoff + m * 2048), PG8_LD16(PG8_SA(b, h) + aoff + m * 2048 + 1024), 0, 1, 2, 3, 4, 5, 6, 7); } \
    else { _Pragma("unroll") for (int m = 0; m < 4; ++m) _Pragma("unroll") for (int k = 0; k < 2; ++k) dst[m][k] = *(const PG8_LAS bf16x8*)(lds + PG8_SA(b, h) + aoff + m * 2048 + k * 1024); } } while (0)
#define PG8_LDB(dst, b, h) do { if constexpr (F8) { _Pragma("unroll") for (int n = 0; n < 2; ++n) dst##8[n] = __builtin_shufflevector(PG8_LD16(PG8_SB(b, h) + boff + n * 2048), PG8_LD16(PG8_SB(b, h) + boff + n * 2048 + 1024), 0, 1, 2, 3, 4, 5, 6, 7); } \
    else { _Pragma("unroll") for (int n = 0; n < 2; ++n) _Pragma("unroll") for (int k = 0; k < 2; ++k) dst[n][k] = *(const PG8_LAS bf16x8*)(lds + PG8_SB(b, h) + boff + n * 2048 + k * 1024); } } while (0)
#define PG8_MMA(ai, bj, At, Bt) do { __builtin_amdgcn_s_setprio(1); if constexpr (F8) { _Pragma("unroll") for (int m = 0; m < 4; ++m) _Pragma("unroll") for (int n = 0; n < 2; ++n) \
        acc[ai][bj][m][n] = __builtin_amdgcn_mfma_scale_f32_16x16x128_f8f6f4(Bt##8[n], At##8[m], acc[ai][bj][m][n], 0, 0, 0, 0x7f7f7f7f, 0, 0x7f7f7f7f); \
        _Pragma("unroll") for (int m = 0; m < 4; ++m) _Pragma("unroll") for (int n = 0; n < 2; ++n) asm volatile("" : "+v"(acc[ai][bj][m][n]));   } \
    else { _Pragma("unroll") for (int m = 0; m < 4; ++m) _Pragma("unroll") for (int n = 0; n < 2; ++n) _Pragma("unroll") for (int k = 0; k < 2; ++k) \
        acc[ai][bj][m][n] = __builtin_amdgcn_mfma_f32_16x16x32_bf16(Bt[n][k], At[m][k], acc[ai][bj][m][n], 0, 0, 0); } __builtin_amdgcn_s_setprio(0); } while (0)
#define PG8_WAIT_V(n) asm volatile("s_waitcnt vmcnt(" #n ")" ::: "memory")
#define PG8_WAIT_L(n) asm volatile("s_waitcnt lgkmcnt(" #n ")" ::: "memory")
#define PG8_BAR __builtin_amdgcn_s_barrier()
#define PG8_SCHED __builtin_amdgcn_sched_barrier(0)
    Unit cur, nxt; int ui = 0;
    if (!S.next(0, cur)) return;
    f32x4 acc[2][2][4][2];
#pragma unroll
    for (int a = 0; a < 2; ++a)
#pragma unroll
        for (int b = 0; b < 2; ++b)
#pragma unroll
            for (int m = 0; m < 4; ++m)
#pragma unroll
                for (int n = 0; n < 2; ++n) acc[a][b][m][n] = (f32x4){0.f, 0.f, 0.f, 0.f};
    bf16x8 At[4][2], B0[2][2], B1[2][2]; pg8_i32x8 At8[4], B08[2], B18[2];
    const char* cA = (const char*)g.A + (size_t)cur.pm * tstep; const char* cB = (const char*)g.Bt + (size_t)cur.pn * tstep;
    S.a_ready(cur);
    PG8_GOFF(gC, cur);
    if constexpr (SP2) {
        const char* nA = cA;
        PG8_STAGE(PG8_SB(0, 0), cB, voffB); PG8_STAGE(PG8_SB(0, 1), cB + hstep, voffB); PG8_STAGE_A(PG8_SA(0, 0), 0, 0, false); PG8_STAGE_A(PG8_SA(0, 1), 0, 1, false);
        if (wr == 1) PG8_BAR;
        PG8_WAIT_V(2); PG8_BAR;
        PG8_STAGE(PG8_SB(1, 0), cB + kstep, voffB); PG8_STAGE_A(PG8_SA(1, 0), kstep, 0, false); PG8_STAGE(PG8_SB(1, 1), cB + hstep + kstep, voffB);
        PG8_WAIT_V(6); PG8_BAR;
    } else {
        const char* nA = cA;
        PG8_STAGE(PG8_SB(0, 0), cB, voffB); PG8_STAGE_A(PG8_SA(0, 0), 0, 0, false); PG8_STAGE(PG8_SB(0, 1), cB + hstep, voffB); PG8_STAGE_A(PG8_SA(0, 1), 0, 1, false);
        if (wr == 1) PG8_BAR;
        PG8_WAIT_V(4); PG8_BAR;
        PG8_STAGE(PG8_SB(1, 0), cB + kstep, voffB); PG8_STAGE_A(PG8_SA(1, 0), kstep, 0, false); PG8_STAGE(PG8_SB(1, 1), cB + hstep + kstep, voffB);
        PG8_WAIT_V(6); PG8_BAR;
    }
    for (;;) {
        const bool has_next = S.next(ui + 1, nxt);
        const char* nA = has_next ? (const char*)g.A + (size_t)nxt.pm * tstep : cA; const char* nB = has_next ? (const char*)g.Bt + (size_t)nxt.pn * tstep : cB;
        if constexpr (GATHER) { if (has_next) PG8_GOFF(gN, nxt); else { _Pragma("unroll") for (int _h = 0; _h < 2; ++_h) _Pragma("unroll") for (int _i = 0; _i < 2; ++_i) gN[_h][_i] = gC[_h][_i]; } }
        for (int t = 0; t < nt; t += 2) {
            const bool last = (t == nt - 2);
            const char* a1 = cA + (size_t)(t + 1) * kstep;
            const char* a2 = last ? nA : cA + (size_t)(t + 2) * kstep; const char* b2 = last ? nB : cB + (size_t)(t + 2) * kstep;
            const char* a3 = a2 + kstep; const char* b3 = b2 + kstep;
            const size_t k1 = (size_t)(t + 1) * kstep, k2 = last ? (size_t)0 : (size_t)(t + 2) * kstep, k3 = k2 + kstep;
            if (last && has_next) S.a_ready(nxt);
            if constexpr (SP2) {
            PG8_LDB(B0, 0, 0); PG8_LDB(B1, 0, 1); PG8_SCHED; PG8_LDA(At, 0, 0); PG8_STAGE_A(PG8_SA(1, 1), k1, 1, false);
            PG8_WAIT_V(8); PG8_WAIT_L(0); PG8_BAR;
            if constexpr (Epi::LDS_BIAS) { if (t == 0) E.stage_bias(cur, lds, wid, lane); }
            PG8_MMA(0, 0, At, B0); PG8_MMA(0, 1, At, B1); PG8_BAR; PG8_SCHED;
            PG8_LDA(At, 0, 1); PG8_STAGE(PG8_SB(0, 0), b2, voffB); PG8_STAGE(PG8_SB(0, 1), b2 + hstep, voffB); PG8_STAGE_A(PG8_SA(0, 0), k2, 0, last);
            PG8_WAIT_V(8); PG8_WAIT_L(0); PG8_BAR; PG8_MMA(1, 0, At, B0); PG8_MMA(1, 1, At, B1); PG8_BAR; PG8_SCHED;
            PG8_LDB(B0, 1, 0); PG8_LDB(B1, 1, 1); PG8_SCHED; PG8_LDA(At, 1, 0); PG8_STAGE_A(PG8_SA(0, 1), k2, 1, last);
            PG8_WAIT_V(8); PG8_WAIT_L(0); PG8_BAR; PG8_MMA(0, 0, At, B0); PG8_MMA(0, 1, At, B1); PG8_BAR; PG8_SCHED;
            PG8_LDA(At, 1, 1); PG8_STAGE(PG8_SB(1, 0), b3, voffB); PG8_STAGE(PG8_SB(1, 1), b3 + hstep, voffB); PG8_STAGE_A(PG8_SA(1, 0), k3, 0, last);
            PG8_WAIT_V(8); PG8_WAIT_L(0); PG8_BAR; PG8_MMA(1, 0, At, B0); PG8_MMA(1, 1, At, B1); PG8_BAR; PG8_SCHED;
            } else {
            PG8_LDB(B0, 0, 0); PG8_SCHED; PG8_LDA(At, 0, 0); PG8_STAGE_A(PG8_SA(1, 1), k1, 1, false);
            PG8_WAIT_L(8); PG8_BAR; PG8_WAIT_L(0); PG8_MMA(0, 0, At, B0); PG8_BAR; PG8_SCHED;
            PG8_LDB(B1, 0, 1); PG8_STAGE(PG8_SB(0, 0), b2, voffB);
            PG8_BAR; PG8_WAIT_L(0); PG8_MMA(0, 1, At, B1); PG8_BAR;
            PG8_LDA(At, 0, 1); PG8_STAGE_A(PG8_SA(0, 0), k2, 0, last);
            PG8_BAR; PG8_WAIT_L(0); PG8_MMA(1, 0, At, B0); PG8_BAR; PG8_SCHED;
            PG8_STAGE(PG8_SB(0, 1), b2 + hstep, voffB);
            PG8_WAIT_V(6); PG8_BAR; PG8_MMA(1, 1, At, B1); PG8_BAR;
            PG8_LDB(B0, 1, 0); PG8_SCHED; PG8_LDA(At, 1, 0); PG8_STAGE_A(PG8_SA(0, 1), k2, 1, last);
            PG8_WAIT_L(8); PG8_BAR; PG8_WAIT_L(0); PG8_MMA(0, 0, At, B0); PG8_BAR; PG8_SCHED;
            PG8_LDB(B1, 1, 1); PG8_STAGE(PG8_SB(1, 0), b3, voffB);
            PG8_BAR; PG8_WAIT_L(0); PG8_MMA(0, 1, At, B1); PG8_BAR;
            PG8_LDA(At, 1, 1); PG8_STAGE_A(PG8_SA(1, 0), k3, 0, last);
            PG8_BAR; PG8_WAIT_L(0); PG8_MMA(1, 0, At, B0); PG8_BAR; PG8_SCHED;
            PG8_STAGE(PG8_SB(1, 1), b3 + hstep, voffB);
            PG8_WAIT_V(6); PG8_BAR; PG8_MMA(1, 1, At, B1); PG8_BAR;
            }
        }
        if constexpr (ALIGN_EPI) { if (wr == 0) PG8_BAR; }
        if constexpr (!Epi::AFTER_DRAIN) { E(acc, cur, wr, wc, fr, fq); S.done(cur); }
        if (!has_next) break;
#pragma unroll
        for (int a = 0; a < 2; ++a)
#pragma unroll
            for (int b = 0; b < 2; ++b)
#pragma unroll
                for (int m = 0; m < 4; ++m)
#pragma unroll
                    for (int n = 0; n < 2; ++n) acc[a][b][m][n] = (f32x4){0.f, 0.f, 0.f, 0.f};
        cur = nxt; cA = nA; cB = nB; ++ui;
        if constexpr (GATHER) { _Pragma("unroll") for (int _h = 0; _h < 2; ++_h) _Pragma("unroll") for (int _i = 0; _i < 2; ++_i) gC[_h][_i] = gN[_h][_i]; }
        if constexpr (ALIGN_EPI) { if (wr == 1) PG8_BAR; }
    }
    PG8_WAIT_V(0);
    if constexpr (!ALIGN_EPI) { if (wr == 0) PG8_BAR; }
    PG8_BAR;
    if constexpr (Epi::AFTER_DRAIN) { E.fused(acc, cur, wr, wc, fr, fq, lds, wid, lane); S.done(cur); }
#undef PG8_SA
#undef PG8_SB
#undef PG8_STAGE
#undef PG8_GOFF
#undef PG8_STAGE_A
#undef PG8_LDA
#undef PG8_LDB
#undef PG8_MMA
#undef PG8_LD16
#undef PG8_WAIT_V
#undef PG8_WAIT_L
#undef PG8_BAR
#undef PG8_SCHED
}
}

#ifndef PG8_SP2
#define PG8_SP2 true
#endif
#ifndef PG8_ALIGN
#define PG8_ALIGN true
#endif
#define GAS __attribute__((address_space(1)))
#define LAS __attribute__((address_space(3)))
typedef unsigned short bf16;
typedef unsigned v4u __attribute__((ext_vector_type(4)));
typedef unsigned v2u __attribute__((ext_vector_type(2)));
typedef float f32x4 __attribute__((ext_vector_type(4)));
typedef short bf16x8 __attribute__((ext_vector_type(8)));
constexpr int D = 1024, NB = 4, SEQ = 4096, CTX = 256, TPB = SEQ + CTX  , T = NB * TPB  , PPB = TPB / 256  ;
constexpr int EVEN_IN = 4128, ODD_IN = 6144, NE = 32, TOPK = 4, DFF = 1024;
constexpr int LDP0 = 4352, LDP1 = 6144;
constexpr int MOE_ROWS = (T * TOPK / 256 + NE) * 256;
constexpr float EPS = 1e-6f;
constexpr int NWAVES = 8, NTHR = 512;
constexpr int LDS_BYTES = 131072 + 4096 + 2048 + 8192;
constexpr int LDS_BIAS_OFF = 131072 + 4096;
constexpr int GDN_NINV_OFF = 131072 + 4096 + 2048;
constexpr int C_GQ = 0, C_GK = 512, C_GV = 1024, C_Z = 1536, C_MQ = 2048, C_MK = 2560, C_MV = 3072, C_MO = 3584, C_AG = 4096, C_BG = 4104, C_IG = 4112, C_FG = 4120;
constexpr int C_RQ = 0, C_RK = 1024, C_RV = 2048, C_RG = 4096;

__device__ __forceinline__ int bid_fresh() { int t = blockIdx.x; asm volatile("" : "+s"(t)); return t; }
__device__ __forceinline__ float sigmoidf_(float x) { return __builtin_amdgcn_rcpf(1.f + __expf(-x)); }
__device__ __forceinline__ float siluf_(float x) { return x * sigmoidf_(x); }
__device__ __forceinline__ float softplusf_(float x) { return fmaxf(x, 0.f) + log1pf(__expf(-fabsf(x))); }
__device__ __forceinline__ float bflo(unsigned u) { return __uint_as_float(u << 16); }
__device__ __forceinline__ float bfhi(unsigned u) { return __uint_as_float(u & 0xffff0000u); }
__device__ __forceinline__ float bf2f(bf16 v) { return __uint_as_float(((unsigned)v) << 16); }
typedef __bf16 hw_bf2 __attribute__((ext_vector_type(2)));
typedef float hw_f2 __attribute__((ext_vector_type(2)));
__device__ __forceinline__ unsigned pk2(float lo, float hi) { const hw_f2 v = {lo, hi}; return __builtin_bit_cast(unsigned, __builtin_convertvector(v, hw_bf2)); }
__device__ __forceinline__ unsigned f2bf(float f) { return pk2(f, 0.f) & 0xffffu; }
__device__ __forceinline__ unsigned pk4_f8(float a, float b, float c2, float d) { int v = __builtin_amdgcn_cvt_pk_fp8_f32(a, b, 0, false); v = __builtin_amdgcn_cvt_pk_fp8_f32(c2, d, v, true); return (unsigned)v; }
__device__ __forceinline__ float shflx(float v, int off, int lane) { return __builtin_bit_cast(float, __builtin_amdgcn_ds_bpermute((lane ^ off) << 2, __builtin_bit_cast(int, v))); }
__device__ __forceinline__ int shflxi(int v, int off, int lane) { return __builtin_amdgcn_ds_bpermute((lane ^ off) << 2, v); }
__device__ __forceinline__ float wave_sum(float v) {
    int ln = (int)__builtin_amdgcn_mbcnt_hi(~0u, __builtin_amdgcn_mbcnt_lo(~0u, 0u)); asm volatile("" : "+v"(ln));
#pragma unroll
    for (int o = 1; o < 64; o <<= 1) v += shflx(v, o, ln);
    return v;
}
__device__ __forceinline__ float wave_sum_dpp(float v) {
#define WS_DPP(x_, ctrl_) __builtin_bit_cast(float, __builtin_amdgcn_update_dpp(0, __builtin_bit_cast(int, x_), ctrl_, 0xf, 0xf, true))
    v += WS_DPP(v, 0xB1); v += WS_DPP(v, 0x4E); v += WS_DPP(v, 0x141); v += WS_DPP(v, 0x140);
#undef WS_DPP
    const int iv = __builtin_bit_cast(int, v);
    const float r0 = __builtin_bit_cast(float, __builtin_amdgcn_readlane(iv, 0)), r1 = __builtin_bit_cast(float, __builtin_amdgcn_readlane(iv, 16)),
                r2 = __builtin_bit_cast(float, __builtin_amdgcn_readlane(iv, 32)), r3 = __builtin_bit_cast(float, __builtin_amdgcn_readlane(iv, 48));
    return (r0 + r1) + (r2 + r3);
}
__device__ __forceinline__ float block_sum256(float v, float* red) {
    v = wave_sum(v);
    __syncthreads();
    if ((threadIdx.x & 63) == 0) red[threadIdx.x >> 6] = v;
    __syncthreads();
    return red[0] + red[1] + red[2] + red[3];
}
__device__ __forceinline__ int seq_pos(int n, int d) { return d == 0 ? n : (n < CTX ? CTX - 1 - n : TPB + CTX - 1 - n); }

struct Params {
    const float *x, *c, *ctx, *c_ctx, *mod_w, *mod_b, *norm1_g, *norm2_g, *ev_w_in, *ev_conv_w, *gdn_a_log, *gdn_dt_bias, *gdn_norm_g, *ml_i_bias, *ml_f_bias, *ml_norm_g, *ev_w_out,
        *od_w_in, *ret_norm_g, *od_w_out, *router_w, *router_b, *moe_w_gu, *moe_b_gu, *moe_w_dn, *moe_b_dn, *final_g;
    float* out;
    unsigned* ctl;
    float* mod;
    float* xres;
    float* rope;
    bf16* od;
    bf16* hb;
    bf16* P;
    bf16* merged;
    bf16 *wt_in0, *wt_out0, *wt_in1, *wt_out1, *wt_gu, *wt_dn;
    bf16 *hs, *act, *yb;
    int *asg_e, *asg_pos, *slot_tok; float* asg_w;
    unsigned char* h8;
    bf16 *rwh, *rwl;
    float* scr0; float* scr1; float* scr2;
};

#define LDS_BARRIER() do { asm volatile("s_waitcnt lgkmcnt(0)" ::: "memory"); __builtin_amdgcn_s_barrier(); asm volatile("" ::: "memory"); } while (0)
typedef const Params __attribute__((address_space(4)))* KP;
#define CP const Params __attribute__((address_space(4)))&
__device__ __forceinline__ KP kp_fresh() { KP q = (KP)__builtin_amdgcn_kernarg_segment_ptr(); asm volatile("" : "+s"(q)); return q; }
#define XB_TMO      128
#define XB_XCNT(j)  (256  + 64 * (j))
#define XB_XSUB(j)  (1280 + 64 * (j))
#define XB_XGEN(j)  (2304 + 64 * (j))
#define XB_TOP      3328
#define XB_TOPGEN   3392
#define XCD_BAR_WORDS 3456
#define XB_SPIN_CAP (1u << 22)

__device__ __forceinline__ unsigned xb_ld(unsigned* p)              { return __hip_atomic_load(p, __ATOMIC_RELAXED, __HIP_MEMORY_SCOPE_AGENT); }
__device__ __forceinline__ unsigned xb_add(unsigned* p, unsigned v) { return __hip_atomic_fetch_add(p, v, __ATOMIC_RELAXED, __HIP_MEMORY_SCOPE_AGENT); }
__device__ __forceinline__ unsigned xb_xcc_id() { return (unsigned)__builtin_amdgcn_s_getreg((3 << 11) | 20) & 0xFu; }
#define XB_SPIN(cond, bar) do { unsigned _sp = 0; while (cond) { __builtin_amdgcn_s_sleep(1); \
    if ((++_sp & 255u) == 0u) { if (xb_ld(&(bar)[XB_TMO])) break; if (_sp > XB_SPIN_CAP) { atomicAdd(&(bar)[XB_TMO], 1u); break; } } } } while (0)

struct XcdBarrier {
    unsigned* bar; unsigned x;
    volatile LAS unsigned* st;
};

__device__ __forceinline__ XcdBarrier xcd_barrier_post(unsigned* bar, volatile LAS unsigned* st) {
    XcdBarrier b; b.bar = bar; b.x = xb_xcc_id(); b.st = st;
    if (tid_fresh() == 0) (void)xb_add(&bar[XB_XCNT(b.x)], 1u);
    return b;
}
__device__ __forceinline__ void xcd_barrier_complete(unsigned* bar, unsigned x, unsigned& nloc, unsigned& nx) {
    const unsigned G = gridDim.x * gridDim.y * gridDim.z;
    unsigned sum, cnt, mine, sp = 0u;
    for (;;) {
        sum = 0u; cnt = 0u; mine = 0u;
#pragma unroll
        for (unsigned j = 0; j < 16; ++j) { const unsigned c = xb_ld(&bar[XB_XCNT(j)]); sum += c; cnt += (c > 0u) ? 1u : 0u; mine = (j == x) ? c : mine; }
        if (sum == G) break;
        __builtin_amdgcn_s_sleep(1);
        if ((++sp & 255u) == 0u) { if (xb_ld(&bar[XB_TMO])) break; if (sp > XB_SPIN_CAP) { atomicAdd(&bar[XB_TMO], 1u); break; } }
    }
    nloc = mine > 0u ? mine : 1u; nx = cnt > 0u ? cnt : 1u;
}

__device__ __forceinline__ void xcd_barrier(const XcdBarrier& b) {
    asm volatile("s_waitcnt vmcnt(0)" ::: "memory");
    __syncthreads();
    if (tid_fresh() == 0) {
        unsigned* bar = b.bar;
        __builtin_amdgcn_s_waitcnt(0);
        unsigned nloc = b.st[0], nx = b.st[1];
        if (nloc == 0u) { xcd_barrier_complete(bar, b.x, nloc, nx); b.st[0] = nloc; b.st[1] = nx; }
        const unsigned old = xb_add(&bar[XB_XSUB(b.x)], 1u);
        const unsigned gen = old / nloc;
        if (old + 1u == (gen + 1u) * nloc) {
            __builtin_amdgcn_fence(__ATOMIC_RELEASE, "agent");
            asm volatile("s_waitcnt vmcnt(0)" ::: "memory");
            const unsigned og = xb_add(&bar[XB_TOP], 1u);
            const unsigned tg = og / nx;
            if (og + 1u == (tg + 1u) * nx) xb_add(&bar[XB_TOPGEN], 1u);
            else XB_SPIN(xb_ld(&bar[XB_TOPGEN]) == tg, bar);
            __builtin_amdgcn_fence(__ATOMIC_ACQUIRE, "agent");
            xb_add(&bar[XB_XGEN(b.x)], 1u);
            asm volatile("s_waitcnt vmcnt(0)" ::: "memory");
        } else {
            XB_SPIN(xb_ld(&bar[XB_XGEN(b.x)]) == gen, bar);
            __builtin_amdgcn_fence(__ATOMIC_ACQUIRE, "agent");
            asm volatile("s_waitcnt vmcnt(0)" ::: "memory");
        }
    }
    __syncthreads();
}

struct MapId { __device__ __forceinline__ int operator()(int n) const { return n; } };
struct MapIn0 { __device__ __forceinline__ int operator()(int n) const { return n < 2048 ? n : (n < 2064 ? 4096 + (n - 2048) : (n < 4112 ? n - 16 : n)); } };
struct MapGu { __device__ __forceinline__ int operator()(int n) const { const int j = n >> 1, s = n & 1; return 256 * (j >> 7) + 128 * s + (j & 127); } };

template <class Map>
__device__ __forceinline__ void transpose_item(const float* W, int K, int N, bf16* WT, LAS float* scr, int item, int lane, Map map) {
    const int nblk = N / 32, kb = item / nblk, nb = item % nblk, k0 = 64 * kb, n0 = 32 * nb;
    float tv[32];
#pragma unroll
    for (int i = 0; i < 32; ++i) tv[i] = __builtin_nontemporal_load(W + (size_t)(k0 + 2 * i + (lane >> 5)) * N + n0 + (lane & 31));
#pragma unroll
    for (int i = 0; i < 32; ++i) scr[(2 * i + (lane >> 5)) * 33 + (lane & 31)] = tv[i];
    asm volatile("s_waitcnt lgkmcnt(0)" ::: "memory");
    const int c = lane & 7;
#pragma unroll
    for (int j = 0; j < 4; ++j) { const int n = (lane >> 3) + 8 * j; const LAS float* s = scr + (8 * c) * 33 + n;
        v4u o; o.x = pk2(s[0 * 33], s[1 * 33]); o.y = pk2(s[2 * 33], s[3 * 33]); o.z = pk2(s[4 * 33], s[5 * 33]); o.w = pk2(s[6 * 33], s[7 * 33]);
        __builtin_nontemporal_store(o, (v4u*)(WT + (size_t)map(n0 + n) * K + k0 + 8 * c)); }
    asm volatile("s_waitcnt lgkmcnt(0)" ::: "memory");
}


constexpr float WSCALE = 32.f, WSCALE_INV = 1.f / 32.f;
template <class Map>
__device__ __forceinline__ void transpose_item_f8(const float* W, int K, int N, unsigned char* WT, LAS float* scr, int item, int lane, Map map) {
    const int nblk = N / 32, kb = item / nblk, nb = item % nblk, k0 = 64 * kb, n0 = 32 * nb;
    float tv[32];
#pragma unroll
    for (int i = 0; i < 32; ++i) tv[i] = __builtin_nontemporal_load(W + (size_t)(k0 + 2 * i + (lane >> 5)) * N + n0 + (lane & 31));
#pragma unroll
    for (int i = 0; i < 32; ++i) scr[(2 * i + (lane >> 5)) * 33 + (lane & 31)] = tv[i] * WSCALE;
    asm volatile("s_waitcnt lgkmcnt(0)" ::: "memory");
    const int c = lane & 7;
#pragma unroll
    for (int j = 0; j < 4; ++j) { const int n = (lane >> 3) + 8 * j; const LAS float* s = scr + (8 * c) * 33 + n;
        v2u o; o.x = pk4_f8(s[0 * 33], s[1 * 33], s[2 * 33], s[3 * 33]); o.y = pk4_f8(s[4 * 33], s[5 * 33], s[6 * 33], s[7 * 33]);
        __builtin_nontemporal_store(o, (v2u*)(WT + (size_t)map(n0 + n) * K + k0 + 8 * c)); }
    asm volatile("s_waitcnt lgkmcnt(0)" ::: "memory");
}

template <class Map>
__device__ __forceinline__ void transpose_item64(const float* W, int K, int N, bf16* WT, LAS float* scr, int item, int lane, Map map) {
    const int nblk = N / 64, kb = item / nblk, nb = item % nblk, k0 = 64 * kb, n0 = 64 * nb;
    float tv[64];
#pragma unroll
    for (int i = 0; i < 64; ++i) tv[i] = __builtin_nontemporal_load(W + (size_t)(k0 + i) * N + n0 + lane);
#pragma unroll
    for (int i = 0; i < 64; ++i) scr[i * 64 + (lane ^ i)] = tv[i];
    asm volatile("s_waitcnt lgkmcnt(0)" ::: "memory");
    const int c = lane & 7;
#pragma unroll
    for (int j = 0; j < 8; ++j) { const int n = (lane >> 3) + 8 * j; const LAS float* s = scr + (8 * c) * 64;
#define TS(e) s[(e) * 64 + (n ^ (8 * c + (e)))]
        v4u o; o.x = pk2(TS(0), TS(1)); o.y = pk2(TS(2), TS(3)); o.z = pk2(TS(4), TS(5)); o.w = pk2(TS(6), TS(7));
#undef TS
        __builtin_nontemporal_store(o, (v4u*)(WT + (size_t)map(n0 + n) * K + k0 + 8 * c)); }
    asm volatile("s_waitcnt lgkmcnt(0)" ::: "memory");
}

__device__ __forceinline__ void ph_prologue(CP p, LAS unsigned char* lds) {
    const int tid = tid_fresh(), lane = tid & 63, wave = tid >> 6, G = gridDim.x;
    const int gw = blockIdx.x * NWAVES + wave, NGW = G * NWAVES;
    LAS float* scond = (LAS float*)(lds + 72 * 1024);
    for (int i = tid; i < 5 * D; i += NTHR) { const int r = i >> 10, k = i & 1023; scond[i] = siluf_(r < 4 ? p.c[r * D + k] : p.c_ctx[k]); }
    __syncthreads();
    LAS float* red = scond + 5 * D;
    for (int it = blockIdx.x; it < 2 * 96; it += G) {
        const int l = it / 96, j = (it % 96) * 64 + lane;
        const float* w = p.mod_w + (size_t)l * D * 6 * D + j;
        float a0 = 0.f, a1 = 0.f, a2 = 0.f, a3 = 0.f, a4 = 0.f;
        const int kb = wave * (D / NWAVES);
#pragma unroll 16
        for (int k = kb; k < kb + D / NWAVES; ++k) { const float wv = w[(size_t)k * 6 * D]; a0 += scond[k] * wv; a1 += scond[D + k] * wv; a2 += scond[2 * D + k] * wv; a3 += scond[3 * D + k] * wv; a4 += scond[4 * D + k] * wv; }
        red[(wave * 5 + 0) * 64 + lane] = a0; red[(wave * 5 + 1) * 64 + lane] = a1; red[(wave * 5 + 2) * 64 + lane] = a2; red[(wave * 5 + 3) * 64 + lane] = a3; red[(wave * 5 + 4) * 64 + lane] = a4;
        __syncthreads();
        if (wave < 5) { float s = p.mod_b[l * 6 * D + j];
#pragma unroll
            for (int ww = 0; ww < NWAVES; ++ww) s += red[(ww * 5 + wave) * 64 + lane];
            p.mod[(size_t)l * 5 * 6 * D + (size_t)wave * 6 * D + j] = s; }
        __syncthreads();
    }
    for (int i = blockIdx.x * NTHR + tid; i < 2 * D * NE; i += G * NTHR) { const int l = i / (D * NE), k = (i / NE) % D, e = i % NE; const float wv = p.router_w[i]; const unsigned hi = f2bf(wv); const float rem = wv - __uint_as_float(hi << 16);
        p.rwh[((size_t)l * NE + e) * D + k] = (bf16)hi; p.rwl[((size_t)l * NE + e) * D + k] = (bf16)f2bf(rem); }
    { v4u z = {0u, 0u, 0u, 0u}; v4u* dst = (v4u*)(p.wt_in0 + (size_t)EVEN_IN * D); const int n16 = (LDP0 - EVEN_IN) * D / 8;
      for (int i = blockIdx.x * NTHR + tid; i < n16; i += G * NTHR) dst[i] = z; }
    for (int i = blockIdx.x * NTHR + tid; i < TPB * 64; i += G * NTHR) { const int pos = i >> 6, fi = i & 63; const float ang = (float)pos * powf(10000.f, -(float)fi / 64.f); float sn, cs; sincosf(ang, &sn, &cs); p.rope[2 * i] = cs; p.rope[2 * i + 1] = sn; }
    __syncthreads();
    LAS float* scr = (LAS float*)(lds + wave * 8448);
    constexpr int I_IN0 = 16 * (EVEN_IN / 32), I_OUT0 = 16 * 32, I_IN1 = 16 * (ODD_IN / 32), I_OUT1 = 32 * 32, I_GU1 = 16 * 64, I_DN1 = 16 * 32;
    constexpr int NITEMS = I_IN0 + I_OUT0 + I_IN1 + I_OUT1 + 32 * I_GU1 + 32 * I_DN1;
    for (int it = gw; it < NITEMS; it += NGW) {
        int r = it;
        if (r < I_IN0) { transpose_item(p.ev_w_in, D, EVEN_IN, p.wt_in0, scr, r, lane, MapIn0()); continue; } r -= I_IN0;
        if (r < I_OUT0) { transpose_item(p.ev_w_out, D, D, p.wt_out0, scr, r, lane, MapId()); continue; } r -= I_OUT0;
        if (r < I_IN1) { transpose_item(p.od_w_in, D, ODD_IN, p.wt_in1, scr, r, lane, MapId()); continue; } r -= I_IN1;
        if (r < I_OUT1) { transpose_item(p.od_w_out, 2 * D, D, p.wt_out1, scr, r, lane, MapId()); continue; } r -= I_OUT1;
        if (r < 32 * I_GU1) { const int m = r / I_GU1; transpose_item_f8(p.moe_w_gu + (size_t)m * D * 2 * DFF, D, 2 * DFF, (unsigned char*)p.wt_gu + (size_t)m * 2 * DFF * D, scr, r % I_GU1, lane, MapGu()); continue; } r -= 32 * I_GU1;
        { const int m = r / I_DN1; transpose_item_f8(p.moe_w_dn + (size_t)m * DFF * D, DFF, D, (unsigned char*)p.wt_dn + (size_t)m * D * DFF, scr, r % I_DN1, lane, MapId()); }
    }
}


constexpr int NDEF = 32 * (16 * 64) + 32 * (16 * 32), FILL_CTR = 9000;
constexpr int FILL_BATCH = 16;
__device__ __forceinline__ void ph_fill(CP p, LAS unsigned char* lds, int s0, int e0, int q) {
    if (s0 >= e0) return;
    const int tid = tid_fresh(), lane = tid & 63, wave = tid >> 6;
    LAS float* scr = (LAS float*)(lds + wave * 8448);
    LAS int* slot = (LAS int*)(lds + 131072 + 1536);
    int* ctr = (int*)p.ctl + FILL_CTR + 64 * q;
    int nxt = 0;
    if (tid == 0) nxt = atomicAdd(ctr, FILL_BATCH);
    for (;;) {
        LDS_BARRIER();
        if (tid == 0) *slot = nxt;
        LDS_BARRIER();
        const int i0 = s0 + *slot;
        if (i0 >= e0) break;
        if (tid == 0) nxt = atomicAdd(ctr, FILL_BATCH);
        for (int k = 0; k < FILL_BATCH / 8; ++k) { const int idx = i0 + wave * (FILL_BATCH / 8) + k; if (idx >= e0) break;
            if (idx < 32 * 1024) { const int m = 32 + (idx >> 10); transpose_item_f8(p.moe_w_gu + (size_t)m * D * 2 * DFF, D, 2 * DFF, (unsigned char*)p.wt_gu + (size_t)m * 2 * DFF * D, scr, idx & 1023, lane, MapGu()); }
            else { const int j = idx - 32 * 1024, m = 32 + (j >> 9); transpose_item_f8(p.moe_w_dn + (size_t)m * DFF * D, DFF, D, (unsigned char*)p.wt_dn + (size_t)m * D * DFF, scr, j & 511, lane, MapId()); } }
    }
}
#ifndef FQ_IN0
#define FQ_IN0 5000
#define FQ_LOCAL 8000
#define FQ_SEQ 23000
#define FQ_OUT0 37000
#define FQ_GU0 37000
#define FQ_DN0 42000
#define FQ_IN1 49152
#endif
#define FILL_IN0 0, FQ_IN0, 0
#define FILL_LOCAL FQ_IN0, FQ_LOCAL, 1
#define FILL_SEQ FQ_LOCAL, FQ_SEQ, 2
#define FILL_OUT0 FQ_SEQ, FQ_OUT0, 3
#define FILL_GU0 FQ_OUT0, FQ_GU0, 4
#define FILL_DN0 FQ_GU0, FQ_DN0, 5
#define FILL_IN1 FQ_DN0, FQ_IN1, 6
#define FILL_CATCH FQ_IN1, NDEF, 7

__device__ __forceinline__ const float* src_row_l0(CP p, int t) {
    const int b = t / TPB, pp = t % TPB;
    return pp < CTX ? p.ctx + ((size_t)b * CTX + pp) * D : p.x + ((size_t)b * SEQ + (pp - CTX)) * D;
}
__device__ __forceinline__ void ph_norm(CP p, int layer, int which  ) {
    const int tid_ = tid_fresh(), lane = tid_ & 63, gw = (tid_ >> 6) * gridDim.x + blockIdx.x, NGW = gridDim.x * NWAVES;
    const float* g = (which ? p.norm2_g : p.norm1_g) + layer * D;
    const float* modl = p.mod + (size_t)layer * 5 * 6 * D + (which ? 3 * D : 0);
    f32x4 gg[4];
#pragma unroll
    for (int j = 0; j < 4; ++j) gg[j] = ((const f32x4*)g + lane)[64 * j];
    f32x4 vn[4], shn[4], scn[4];
#define NRM_LOAD(t_) do { const int b_ = (t_) / TPB, pp_ = (t_) % TPB, r_ = pp_ < CTX ? 4 : b_; const f32x4* x4_ = (const f32x4*)src_row_l0(p, (t_)) + lane; \
        const f32x4* sh4_ = (const f32x4*)(modl + (size_t)r_ * 6 * D) + lane; \
        _Pragma("unroll") for (int j = 0; j < 4; ++j) { vn[j] = x4_[64 * j]; shn[j] = sh4_[64 * j]; scn[j] = sh4_[D / 4 + 64 * j]; } } while (0)
    int t = gw;
    if (t < T) NRM_LOAD(t);
    for (; t < T; t += NGW) {
        f32x4 v[4], sh[4], sc[4]; float s = 0.f;
#pragma unroll
        for (int j = 0; j < 4; ++j) { v[j] = vn[j]; sh[j] = shn[j]; sc[j] = scn[j]; }
        if (t + NGW < T) NRM_LOAD(t + NGW);
#pragma unroll
        for (int j = 0; j < 4; ++j) s += (v[j].x * v[j].x + v[j].y * v[j].y) + (v[j].z * v[j].z + v[j].w * v[j].w);
        const float rs = rsqrtf(wave_sum(s) * (1.f / D) + EPS);
#pragma unroll
        for (int j = 0; j < 4; ++j) {
            f32x4 h; h.x = (v[j].x * rs * gg[j].x) * (1.f + sc[j].x) + sh[j].x; h.y = (v[j].y * rs * gg[j].y) * (1.f + sc[j].y) + sh[j].y; h.z = (v[j].z * rs * gg[j].z) * (1.f + sc[j].z) + sh[j].z; h.w = (v[j].w * rs * gg[j].w) * (1.f + sc[j].w) + sh[j].w;
            v2u o; o.x = pk2(h.x, h.y); o.y = pk2(h.z, h.w);
            *((v2u*)(p.hb + (size_t)t * D) + lane + 64 * j) = o;
        }
    }
#undef NRM_LOAD
}

struct LatOrder {
    int G, c;
    __device__ __forceinline__ bool next(int i, pg8::Unit& u) const { const int L = i * G + c; if (L >= 64 * 4) return false; const int q = L >> 2; u.pm = (q >> 4) * PPB + 1 + (q & 15); u.pn = L & 3; return true; }
    __device__ __forceinline__ void a_ready(const pg8::Unit&) const {}
    __device__ __forceinline__ void done(const pg8::Unit&) const {}
};
struct MoeOrder {
    const int* base; int ntn, G, c;
    __device__ __forceinline__ bool next(int i, pg8::Unit& u) const {
        const int nb = __builtin_amdgcn_readfirstlane(base[NE]) >> 8, per = (nb + 7) >> 3, x = c & 7, ul = i * (G >> 3) + (c >> 3);
        const int rbl = ul / ntn, pn = ul % ntn, rb = x * per + rbl; if (rbl >= per || rb >= nb) return false;
        const int r0 = rb << 8; int e = 0;
        for (int k = 1; k < NE; ++k) e = (r0 >= __builtin_amdgcn_readfirstlane(base[k])) ? k : e;
        u.pm = __builtin_amdgcn_readfirstlane(rb); u.pn = __builtin_amdgcn_readfirstlane(e * ntn + pn); return true;
    }
    __device__ __forceinline__ void a_ready(const pg8::Unit&) const {}
    __device__ __forceinline__ void done(const pg8::Unit&) const {}
};
struct MoeGatherOrder {
    const int* base  ; const int* slot_tok; int ntn, G, c;
    __device__ __forceinline__ bool next(int i, pg8::Unit& u) const {
        const int nb = __builtin_amdgcn_readfirstlane(base[NE]) >> 8, per = (nb + 7) >> 3, x = c & 7, ul = i * (G >> 3) + (c >> 3);
        const int rbl = ul / ntn, pn = ul % ntn, rb = x * per + rbl; if (rbl >= per || rb >= nb) return false;
        const int r0 = rb << 8; int e = 0;
        for (int k = 1; k < NE; ++k) e = (r0 >= __builtin_amdgcn_readfirstlane(base[k])) ? k : e;
        u.pm = __builtin_amdgcn_readfirstlane(rb); u.pn = __builtin_amdgcn_readfirstlane(e * ntn + pn); return true;
    }
    __device__ __forceinline__ unsigned a_off(const pg8::Unit& u, int r) const {
        const int e = u.pn / ntn, lb0 = (u.pm << 8) - __builtin_amdgcn_readfirstlane(base[e]), cnt_e = __builtin_amdgcn_readfirstlane(base[40 + e]), local = lb0 + r;
        const int tok = local < cnt_e ? slot_tok[e * T + local] : 0;
        return (unsigned)tok * (unsigned)D;
    }
    __device__ __forceinline__ void a_ready(const pg8::Unit&) const {}
    __device__ __forceinline__ void done(const pg8::Unit&) const {}
};
struct MoeCapOrder {
    const int* base; int ntn, G, c;
    __device__ __forceinline__ bool next(int i, pg8::Unit& u) const {
        const int nb = __builtin_amdgcn_readfirstlane(base[NE]) >> 8, per = (nb + 7) >> 3, x = c & 7, ul = i * (G >> 3) + (c >> 3);
        const int rbl = ul / ntn, pn = ul % ntn, rb = x * per + rbl; if (rbl >= per || rb >= nb) return false;
        const int e = __builtin_amdgcn_readfirstlane((int)((const unsigned char*)base)[320 + rb]);
        const int lb = rb - (__builtin_amdgcn_readfirstlane(base[e]) >> 8);
        u.pm = __builtin_amdgcn_readfirstlane(e * (T / 256) + lb); u.pn = __builtin_amdgcn_readfirstlane(e * ntn + pn); return true;
    }
    __device__ __forceinline__ void a_ready(const pg8::Unit&) const {}
    __device__ __forceinline__ void done(const pg8::Unit&) const {}
};
struct EpiResid {
    static constexpr bool PERM = false, AFTER_DRAIN = false, LDS_BIAS = false;
    const float* x; const float* ctx; bf16* xres; const float* gate  ; int layer0;
    __device__ __forceinline__ void operator()(const pg8::f32x4 (&acc)[2][2][4][2], const pg8::Unit& u, int wr, int wc, int fr, int fq) const {
        const int b = u.pm / PPB, j = u.pm % PPB, r = j == 0 ? 4 : b;
        const int col0 = u.pn * 256 + wc * 32 + 4 * fq;
        const float* gp = gate + (size_t)r * 6 * D + col0;
        pg8::f32x4 gv[2][2];
#pragma unroll
        for (int bj = 0; bj < 2; ++bj)
#pragma unroll
            for (int n = 0; n < 2; ++n) gv[bj][n] = *(const pg8::f32x4*)(gp + bj * 128 + n * 16);
#pragma unroll
        for (int ai = 0; ai < 2; ++ai)
#pragma unroll
            for (int m = 0; m < 4; ++m) {
                const int rl = ai * 128 + wr * 64 + m * 16 + fr, t = u.pm * 256 + rl;
                const float* sp = j == 0 ? ctx + ((size_t)b * CTX + rl) * D : x + ((size_t)b * SEQ + (j - 1) * 256 + rl) * D;
                bf16* op = xres + (size_t)t * D;
#pragma unroll
                for (int bj = 0; bj < 2; ++bj)
#pragma unroll
                    for (int n = 0; n < 2; ++n) { const int cc = col0 + bj * 128 + n * 16; pg8::f32x4 s;
                        if (layer0) s = *(const pg8::f32x4*)(sp + cc); else { const v2u sb = *(const v2u*)(op + cc); s = (pg8::f32x4){bflo(sb.x), bfhi(sb.x), bflo(sb.y), bfhi(sb.y)}; }
                        const pg8::f32x4 o = s + gv[bj][n] * acc[ai][bj][m][n]; v2u ob; ob.x = pk2(o[0], o[1]); ob.y = pk2(o[2], o[3]); *(v2u*)(op + cc) = ob; }
            }
    }
};
struct EpiSwiglu {
    static constexpr bool PERM = true, AFTER_DRAIN = false, LDS_BIAS = true;
    unsigned char* act; const float* b_gu  ; const int* base;
    __device__ __forceinline__ void stage_bias(const pg8::Unit& u, LAS unsigned char* lds, int wid, int lane) const {
        const int e = u.pn >> 3, pn = u.pn & 7;
        __builtin_amdgcn_global_load_lds((const unsigned*)(b_gu + (size_t)e * 2 * DFF + 256 * pn + 64 * (wid & 3) + lane), (LAS unsigned*)(lds + LDS_BIAS_OFF + (wid >> 2) * 1024 + (wid & 3) * 256), 4, 0, 0);
    }
    __device__ __forceinline__ void operator()(const pg8::f32x4 (&acc)[2][2][4][2], const pg8::Unit& u, int wr, int wc, int fr, int fq) const {
        const int ln_ = tid_fresh() & 63; fr = ln_ & 15; fq = ln_ >> 4;
        const int e = u.pn >> 3, pn = u.pn & 7, j0 = 128 * pn + 32 * wc + 8 * fq;
        const int rowblk = (__builtin_amdgcn_readfirstlane(base[e]) >> 8) + (u.pm - e * (T / 256));
        extern __shared__ __attribute__((aligned(16))) unsigned char lds_raw_e[];
        const LAS float* bp = (const LAS float*)((LAS unsigned char*)lds_raw_e + LDS_BIAS_OFF) + wr * 256 + 64 * wc + 16 * fq;
#pragma unroll
        for (int n = 0; n < 2; ++n) {
            const pg8::f32x4 b0 = *(const LAS pg8::f32x4*)(bp + 8 * n), b1 = *(const LAS pg8::f32x4*)(bp + 8 * n + 4);
            typedef float sw_f2 __attribute__((ext_vector_type(2)));
            const sw_f2 gb2[2] = {{b0[0], b0[2]}, {b1[0], b1[2]}}, ub2[2] = {{b0[1] + 1.f, b0[3] + 1.f}, {b1[1] + 1.f, b1[3] + 1.f}};
#pragma unroll
            for (int ai = 0; ai < 2; ++ai)
#pragma unroll
                for (int m = 0; m < 4; ++m) {
                    const int row = rowblk * 256 + ai * 128 + wr * 64 + m * 16 + fr;
                    sw_f2 o[2];
#pragma unroll
                    for (int h = 0; h < 2; ++h) {
                        sw_f2 g = (sw_f2){acc[ai][0][m][n][2 * h], acc[ai][0][m][n][2 * h + 1]} * WSCALE_INV + gb2[h];
                        sw_f2 u = (sw_f2){acc[ai][1][m][n][2 * h], acc[ai][1][m][n][2 * h + 1]} * WSCALE_INV + ub2[h];
                        g.x = fminf(g.x, 7.f); g.y = fminf(g.y, 7.f);
                        u.x = __builtin_amdgcn_fmed3f(u.x, -6.f, 8.f); u.y = __builtin_amdgcn_fmed3f(u.y, -6.f, 8.f);
                        sw_f2 e = g * (-1.702f * 1.44269504089f);
                        e.x = __builtin_amdgcn_exp2f(e.x); e.y = __builtin_amdgcn_exp2f(e.y);
                        e = e + 1.f;
                        sw_f2 r; r.x = __builtin_amdgcn_rcpf(e.x); r.y = __builtin_amdgcn_rcpf(e.y);
                        o[h] = (u * g) * r;
                    }
                    *(unsigned*)(act + (size_t)row * DFF + j0 + 4 * n) = pk4_f8(o[0].x, o[0].y, o[1].x, o[1].y);
                }
            asm volatile("" ::: "memory");
        }
    }
};
struct EpiDown {
    static constexpr bool PERM = true, AFTER_DRAIN = false, LDS_BIAS = true;
    bf16* yb; const float* b_dn  ;
    __device__ __forceinline__ void stage_bias(const pg8::Unit& u, LAS unsigned char* lds, int wid, int lane) const {
        const int e = u.pn >> 2, pn = u.pn & 3;
        __builtin_amdgcn_global_load_lds((const unsigned*)(b_dn + (size_t)e * D + 256 * pn + 64 * (wid & 3) + lane), (LAS unsigned*)(lds + LDS_BIAS_OFF + (wid >> 2) * 1024 + (wid & 3) * 256), 4, 0, 0);
    }
    __device__ __forceinline__ void operator()(const pg8::f32x4 (&acc)[2][2][4][2], const pg8::Unit& u, int wr, int wc, int fr, int fq) const {
        const int ln_ = tid_fresh() & 63; fr = ln_ & 15; fq = ln_ >> 4;
        const int e = u.pn >> 2, pn = u.pn & 3, col0 = 256 * pn + 32 * wc + 8 * fq;
        extern __shared__ __attribute__((aligned(16))) unsigned char lds_raw_e[];
        const LAS float* bp = (const LAS float*)((LAS unsigned char*)lds_raw_e + LDS_BIAS_OFF) + wr * 256 + 32 * wc + 8 * fq;
        pg8::f32x4 bv[2][2];
#pragma unroll
        for (int bj = 0; bj < 2; ++bj)
#pragma unroll
            for (int n = 0; n < 2; ++n) bv[bj][n] = *(const LAS pg8::f32x4*)(bp + bj * 128 + 4 * n);
#pragma unroll
        for (int ai = 0; ai < 2; ++ai)
#pragma unroll
            for (int m = 0; m < 4; ++m) {
                const int row = u.pm * 256 + ai * 128 + wr * 64 + m * 16 + fr;
#pragma unroll
                for (int bj = 0; bj < 2; ++bj) { const pg8::f32x4 v0 = acc[ai][bj][m][0] * WSCALE_INV + bv[bj][0], v1 = acc[ai][bj][m][1] * WSCALE_INV + bv[bj][1];
                    pg8::u32x4 w; w.x = pg8::cvt_pk_bf16(v0[0], v0[1]); w.y = pg8::cvt_pk_bf16(v0[2], v0[3]); w.z = pg8::cvt_pk_bf16(v1[0], v1[1]); w.w = pg8::cvt_pk_bf16(v1[2], v1[3]);
                    *(pg8::u32x4*)(yb + (size_t)row * D + col0 + bj * 128) = w; }
            }
    }
};

__device__ __forceinline__ void ph_gemm_in(CP p, LAS unsigned char* lds, int layer) {
    const int N = layer ? LDP1 : LDP0;
    pg8::Gemm g{p.hb, layer ? p.wt_in1 : p.wt_in0, T, N, D}; pg8::StaticOrder S; S.init(T, N, gridDim.x, blockIdx.x);
    pg8::EpiBf16<0> E{p.P, N, nullptr, 0, 0, 1.f};
    pg8::gemm_phase<pg8::EpiBf16<0>, pg8::StaticOrder, PG8_ALIGN, PG8_SP2>(lds, g, S, E);
    if (layer) ph_fill(p, lds, FILL_IN1); else ph_fill(p, lds, FILL_IN0);
}
__device__ __forceinline__ void ph_gemm_out(CP p, LAS unsigned char* lds, int layer) {
    EpiResid E{p.x, p.ctx, (bf16*)p.xres, p.mod + (size_t)layer * 5 * 6 * D + 2 * D, layer == 0 ? 1 : 0};
    if (layer == 0) { pg8::Gemm g{p.merged, p.wt_out0, T, D, D}; pg8::StaticOrder S; S.init(T, D, gridDim.x, blockIdx.x);
        pg8::gemm_phase<EpiResid, pg8::StaticOrder, PG8_ALIGN, PG8_SP2>(lds, g, S, E); ph_fill(p, lds, FILL_OUT0); }
    else { pg8::Gemm g{p.merged, p.wt_out1, T, D, 2 * D}; LatOrder S{(int)gridDim.x, (int)blockIdx.x};
        pg8::gemm_phase<EpiResid, LatOrder, PG8_ALIGN, PG8_SP2>(lds, g, S, E); }
}
__device__ __forceinline__ void ph_moe_gu(CP p, LAS unsigned char* lds, int layer, const int* base) {
    pg8::Gemm g{(const pg8::bf16_t*)p.hs, (const pg8::bf16_t*)((const unsigned char*)p.wt_gu + (size_t)layer * NE * 2 * DFF * D), NE * T, 2 * DFF, D / 2}; MoeCapOrder S{base, 8, (int)gridDim.x, (int)blockIdx.x};
    EpiSwiglu E{(unsigned char*)p.act, p.moe_b_gu + (size_t)layer * NE * 2 * DFF, base};
    pg8::gemm_phase<EpiSwiglu, MoeCapOrder, PG8_ALIGN, PG8_SP2, false, true>(lds, g, S, E);
    if (layer == 0) ph_fill(p, lds, FILL_GU0);
}
__device__ __forceinline__ void ph_moe_dn(CP p, LAS unsigned char* lds, int layer, const int* base) {
    pg8::Gemm g{(const pg8::bf16_t*)p.act, (const pg8::bf16_t*)((const unsigned char*)p.wt_dn + (size_t)layer * NE * D * DFF), MOE_ROWS, D, DFF / 2}; MoeOrder S{base, 4, (int)gridDim.x, (int)blockIdx.x};
    EpiDown E{p.yb, p.moe_b_dn + (size_t)layer * NE * D};
    pg8::gemm_phase<EpiDown, MoeOrder, PG8_ALIGN, PG8_SP2, false, true>(lds, g, S, E);
    if (layer == 0) ph_fill(p, lds, FILL_DN0);
}

constexpr int PQ = 144, PS = 80, PST = 136, PP = 72;
__device__ __forceinline__ bf16x8 ldfrag(const LAS bf16* base, int pitch, int row0, int k0, int lane) { return *(const LAS bf16x8*)(base + (row0 + (lane & 15)) * pitch + k0 + 8 * (lane >> 4)); }
typedef short s16x4 __attribute__((ext_vector_type(4)));
__device__ __forceinline__ bf16x8 ldfrag_tr(const LAS bf16* base, int pitch, int m0, int k0, int lane) {
    const LAS bf16* a0 = base + (k0 + 8 * (lane >> 4) + ((lane & 15) >> 2)) * pitch + m0 + 4 * (lane & 3);
    const s16x4 lo = __builtin_amdgcn_ds_read_tr16_b64_v4i16((LAS s16x4*)a0);
    const s16x4 hi = __builtin_amdgcn_ds_read_tr16_b64_v4i16((LAS s16x4*)(a0 + 4 * pitch));
    return (bf16x8){lo[0], lo[1], lo[2], lo[3], hi[0], hi[1], hi[2], hi[3]};
}
constexpr int TRSKEW = 64;
__device__ __forceinline__ bf16x8 ldfrag_trs(const LAS bf16* base, int pitch, int m0, int k0, int lane) {
    const LAS bf16* a0 = base + (k0 + 8 * (lane >> 4) + ((lane & 15) >> 2)) * pitch + ((k0 >> 3) + (lane >> 4)) * TRSKEW + m0 + 4 * (lane & 3);
    const s16x4 lo = __builtin_amdgcn_ds_read_tr16_b64_v4i16((LAS s16x4*)a0);
    const s16x4 hi = __builtin_amdgcn_ds_read_tr16_b64_v4i16((LAS s16x4*)(a0 + 4 * pitch));
    return (bf16x8){lo[0], lo[1], lo[2], lo[3], hi[0], hi[1], hi[2], hi[3]};
}
#define MFMA16(x, y, acc) __builtin_amdgcn_mfma_f32_16x16x32_bf16(x, y, acc, 0, 0, 0)
__device__ __forceinline__ int chunk_of_step(int j, int d) { return d == 0 ? j : (j < 4 ? 3 - j : 71 - j); }

__device__ __forceinline__ void ph_ret_scan(CP p, LAS unsigned char* lds) {
    const int tid = tid_fresh(), lane = tid & 63, w = __builtin_amdgcn_readfirstlane(tid >> 6), r16 = lane & 15, q4 = lane >> 4;
    LAS bf16* Qs = (LAS bf16*)lds;
    LAS bf16* Ks = Qs + 64 * PQ;
    LAS bf16* Vs = Ks + 64 * PQ;
    LAS bf16* Vts = Vs + 64 * PS + 8 * TRSKEW;
    LAS bf16* Ps = Vts + 64 * PS + 8 * TRSKEW;
    LAS bf16* St = Ps + 64 * PP;
    const bf16* Pm = p.P; const float* rope = p.rope; bf16* od = p.od;
    for (int item = bid_fresh(); item < 256; item += gridDim.x) {
        const int itx = 4 * (((item >> 3) >> 2) * 8 + (item & 7)) + ((item >> 3) & 3);
        const int sl = itx & 3, d = (itx >> 2) & 1, h = (itx >> 3) & 7, b = itx >> 6;
        const float lg2 = log2f(1.f - exp2f(-(5.f + (float)(d ? 7 - h : h))));
        const float g64 = exp2f(64.f * lg2);
        f32x4 S[4];
#pragma unroll
        for (int n = 0; n < 4; ++n) S[n] = (f32x4){0.f, 0.f, 0.f, 0.f};
        asm volatile("" : "+v"(S[0]), "+v"(S[1]), "+v"(S[2]), "+v"(S[3]));
        v4u A_rq0, A_rq1, A_rk0, A_rk1, A_rv, B_rq0, B_rq1, B_rk0, B_rk1, B_rv; f32x4 A_c0, A_c1, A_c2, A_c3, B_c0, B_c1, B_c2, B_c3;
        const int mr = tid >> 3, cc = tid & 7, ir = d ? 63 - mr : mr;
#define RET_LOAD(jj, X) do { const int pos_ = 64 * (jj) + mr; const bf16* row_ = Pm + (size_t)(b * TPB + pos_) * LDP1; \
            X##rq0 = *(const v4u*)(row_ + C_RQ + h * 128 + 8 * cc); X##rq1 = *(const v4u*)(row_ + C_RQ + h * 128 + 64 + 8 * cc); \
            X##rk0 = *(const v4u*)(row_ + C_RK + h * 128 + 8 * cc); X##rk1 = *(const v4u*)(row_ + C_RK + h * 128 + 64 + 8 * cc); \
            X##rv = *(const v4u*)(row_ + C_RV + h * 256 + sl * 64 + 8 * cc); \
            const f32x4* rp_ = (const f32x4*)(rope + ((size_t)pos_ * 64 + 8 * cc) * 2); X##c0 = rp_[0]; X##c1 = rp_[1]; X##c2 = rp_[2]; X##c3 = rp_[3]; } while (0)
        RET_LOAD(chunk_of_step(0, d), A_); RET_LOAD(chunk_of_step(1, d), B_);
        const float tail = exp2f(lg2 * (float)(63 - ir));
#define RET_STEP(j, X, Y) do { \
            const int jj = chunk_of_step(j, d); \
            LDS_BARRIER(); \
            { \
                const unsigned qa[4] = {X##rq0.x, X##rq0.y, X##rq0.z, X##rq0.w}, qb[4] = {X##rq1.x, X##rq1.y, X##rq1.z, X##rq1.w}, ka[4] = {X##rk0.x, X##rk0.y, X##rk0.z, X##rk0.w}, kb[4] = {X##rk1.x, X##rk1.y, X##rk1.z, X##rk1.w}, va[4] = {X##rv.x, X##rv.y, X##rv.z, X##rv.w}; \
                const f32x4 cs[4] = {X##c0, X##c1, X##c2, X##c3}; \
                unsigned oq0[4], oq1[4], ok0[4], ok1[4], ovt[4]; \
_Pragma("unroll") \
                for (int u = 0; u < 4; ++u) { \
                    const float cA = cs[u].x, sA = cs[u].y, cB = cs[u].z, sB = cs[u].w; \
                    const float q0a = bflo(qa[u]), q0b = bfhi(qa[u]), q1a = bflo(qb[u]), q1b = bfhi(qb[u]); \
                    const float k0a = bflo(ka[u]) * 0.08838834764831845f, k0b = bfhi(ka[u]) * 0.08838834764831845f, k1a = bflo(kb[u]) * 0.08838834764831845f, k1b = bfhi(kb[u]) * 0.08838834764831845f; \
                    oq0[u] = pk2(q0a * cA - q1a * sA, q0b * cB - q1b * sB); oq1[u] = pk2(q0a * sA + q1a * cA, q0b * sB + q1b * cB); \
                    ok0[u] = pk2(k0a * cA - k1a * sA, k0b * cB - k1b * sB); ok1[u] = pk2(k0a * sA + k1a * cA, k0b * sB + k1b * cB); \
                    ovt[u] = pk2(bflo(va[u]) * tail, bfhi(va[u]) * tail); \
                } \
                *(LAS v4u*)(Qs + ir * PQ + 8 * cc) = (v4u){oq0[0], oq0[1], oq0[2], oq0[3]}; *(LAS v4u*)(Qs + ir * PQ + 64 + 8 * cc) = (v4u){oq1[0], oq1[1], oq1[2], oq1[3]}; \
                *(LAS v4u*)(Ks + ir * PQ + 8 * cc) = (v4u){ok0[0], ok0[1], ok0[2], ok0[3]}; *(LAS v4u*)(Ks + ir * PQ + 64 + 8 * cc) = (v4u){ok1[0], ok1[1], ok1[2], ok1[3]}; \
                *(LAS v4u*)(Vs + ir * PS + (ir >> 3) * TRSKEW + 8 * cc) = X##rv; *(LAS v4u*)(Vts + ir * PS + (ir >> 3) * TRSKEW + 8 * cc) = (v4u){ovt[0], ovt[1], ovt[2], ovt[3]}; \
_Pragma("unroll") \
                for (int n = 0; n < 4; ++n) { v2u o; o.x = pk2(S[n][0], S[n][1]); o.y = pk2(S[n][2], S[n][3]); *(LAS v2u*)(St + (16 * n + r16) * PST + 16 * w + 4 * q4) = o; } \
            } \
            LDS_BARRIER(); \
            if (j + 2 < 68) RET_LOAD(chunk_of_step(j + 2, d), X); \
            const int ct = w >> 1, h2 = (w & 1) * 2; \
            bf16x8 qf[4]; \
_Pragma("unroll") \
            for (int ks = 0; ks < 4; ++ks) qf[ks] = ldfrag(Qs, PQ, 16 * ct, 32 * ks, lane); \
            { \
                f32x4 a0 = {0.f, 0.f, 0.f, 0.f}, a1 = {0.f, 0.f, 0.f, 0.f}; \
                if (h2 <= ct) { \
_Pragma("unroll") \
                    for (int ks = 0; ks < 4; ++ks) { const bf16x8 a = qf[ks]; a0 = MFMA16(ldfrag(Ks, PQ, 16 * h2, 32 * ks, lane), a, a0); a1 = MFMA16(ldfrag(Ks, PQ, 16 * (h2 + 1), 32 * ks, lane), a, a1); } \
                } \
                const int c = 16 * ct + r16; \
_Pragma("unroll") \
                for (int n = 0; n < 2; ++n) { const f32x4 a = n ? a1 : a0; float o[4]; \
_Pragma("unroll") \
                    for (int i = 0; i < 4; ++i) { const int s = 16 * (h2 + n) + 4 * q4 + i; o[i] = c >= s ? a[i] * __builtin_amdgcn_exp2f(lg2 * (float)(c - s)) : 0.f; } \
                    v2u pk; pk.x = pk2(o[0], o[1]); pk.y = pk2(o[2], o[3]); *(LAS v2u*)(Ps + c * PP + 16 * (h2 + n) + 4 * q4) = pk; } \
            } \
            f32x4 b0 = {0.f, 0.f, 0.f, 0.f}, b1 = {0.f, 0.f, 0.f, 0.f}; \
            if (jj >= 4) { \
_Pragma("unroll") \
                for (int ks = 0; ks < 4; ++ks) { const bf16x8 a = qf[ks]; b0 = MFMA16(ldfrag(St, PST, 16 * h2, 32 * ks, lane), a, b0); b1 = MFMA16(ldfrag(St, PST, 16 * (h2 + 1), 32 * ks, lane), a, b1); } \
            } \
            LDS_BARRIER(); \
            if (jj >= 4) { \
                f32x4 a0 = {0.f, 0.f, 0.f, 0.f}, a1 = {0.f, 0.f, 0.f, 0.f}; \
_Pragma("unroll") \
                for (int ks = 0; ks < 2; ++ks) { const bf16x8 a = ldfrag(Ps, PP, 16 * ct, 32 * ks, lane); a0 = MFMA16(ldfrag_trs(Vs, PS, 16 * h2, 32 * ks, lane), a, a0); a1 = MFMA16(ldfrag_trs(Vs, PS, 16 * (h2 + 1), 32 * ks, lane), a, a1); } \
                const int c = 16 * ct + r16, mm = d ? 63 - c : c; const float cr = __builtin_amdgcn_exp2f(lg2 * (float)(c + 1)); \
                bf16* orow = od + ((size_t)d * T + b * TPB + 64 * jj + mm) * 2048 + h * 256 + sl * 64 + 4 * q4; \
                { v2u o; o.x = pk2(a0[0] + cr * b0[0], a0[1] + cr * b0[1]); o.y = pk2(a0[2] + cr * b0[2], a0[3] + cr * b0[3]); *(v2u*)(orow + 16 * h2) = o; } \
                { v2u o; o.x = pk2(a1[0] + cr * b1[0], a1[1] + cr * b1[1]); o.y = pk2(a1[2] + cr * b1[2], a1[3] + cr * b1[3]); *(v2u*)(orow + 16 * (h2 + 1)) = o; } \
            } \
            { \
_Pragma("unroll") \
                for (int n = 0; n < 4; ++n) S[n] = S[n] * g64; \
_Pragma("unroll") \
                for (int ks = 0; ks < 2; ++ks) { const bf16x8 a = ldfrag_tr(Ks, PQ, 16 * w, 32 * ks, lane); \
_Pragma("unroll") \
                    for (int n = 0; n < 4; ++n) S[n] = MFMA16(a, ldfrag_trs(Vts, PS, 16 * n, 32 * ks, lane), S[n]); } \
            } \
} while (0)
        for (int j = 0; j < 68; j += 2) { RET_STEP(j, A_, B_); RET_STEP(j + 1, B_, A_); }
#undef RET_LOAD
    }
}
__device__ __forceinline__ void ph_merge_odd(CP p) {
    const int tid = tid_fresh(), h = tid >> 6, lane = tid & 63;
    const bf16* od = p.od + h * 256 + lane * 4; const bf16* gp = p.P + C_RG + h * 256 + lane * 4;
    const f32x4 ng = *(const f32x4*)(p.ret_norm_g + h * 256 + lane * 4);
    v2u na[4], nb_[4], ngt[4];
#define MO_LOAD(l0_) do { _Pragma("unroll") for (int u = 0; u < 4; ++u) { const int tl = (l0_) + u; const size_t t = (size_t)(tl >> 12) * TPB + CTX + (tl & 4095); \
            na[u] = *(const v2u*)(od + t * 2048); nb_[u] = *(const v2u*)(od + t * 2048 + (size_t)T * 2048); ngt[u] = *(const v2u*)(gp + t * LDP1); } } while (0)
    if ((int)blockIdx.x * 4 < NB * SEQ) MO_LOAD((int)blockIdx.x * 4);
    for (int l0 = blockIdx.x * 4; l0 < NB * SEQ; l0 += gridDim.x * 4) {
        v2u va[4], vb[4], vg[4];
#pragma unroll
        for (int u = 0; u < 4; ++u) { va[u] = na[u]; vb[u] = nb_[u]; vg[u] = ngt[u]; }
        if (l0 + (int)gridDim.x * 4 < NB * SEQ) MO_LOAD(l0 + (int)gridDim.x * 4);
#pragma unroll
        for (int u = 0; u < 4; ++u) { const int tl = l0 + u; const size_t t = (size_t)(tl >> 12) * TPB + CTX + (tl & 4095);
            f32x4 v; v.x = bflo(va[u].x) + bflo(vb[u].x); v.y = bfhi(va[u].x) + bfhi(vb[u].x); v.z = bflo(va[u].y) + bflo(vb[u].y); v.w = bfhi(va[u].y) + bfhi(vb[u].y);
            const float mean = wave_sum((v.x + v.y) + (v.z + v.w)) * (1.f / 256.f);
            v = v - mean;
            const float rs = rsqrtf(wave_sum((v.x * v.x + v.y * v.y) + (v.z * v.z + v.w * v.w)) * (1.f / 256.f) + EPS);
            v2u o; o.x = pk2(v.x * rs * ng.x * siluf_(bflo(vg[u].x)), v.y * rs * ng.y * siluf_(bfhi(vg[u].x))); o.y = pk2(v.z * rs * ng.z * siluf_(bflo(vg[u].y)), v.w * rs * ng.w * siluf_(bfhi(vg[u].y)));
            *(v2u*)(p.merged + t * 2048 + h * 256 + lane * 4) = o; }
    }
}
#undef MO_LOAD

constexpr int PV = 80;
__device__ __forceinline__ void ph_mlstm_scan(CP p, LAS unsigned char* lds, int first_block, int nblocks) {
    const int tid = tid_fresh(), lane = tid & 63, w = __builtin_amdgcn_readfirstlane(tid >> 6), r16 = lane & 15, q4 = lane >> 4;
    LAS bf16* Qs = (LAS bf16*)lds;
    LAS bf16* Ks = Qs + 64 * PQ;
    LAS bf16* Vs = Ks + 64 * PQ;
    LAS bf16* Vts = Vs + 64 * PV + 8 * TRSKEW;
    LAS bf16* Ps = Vts + 64 * PV + 8 * TRSKEW;
    LAS bf16* St = Ps + 64 * PP;
    LAS float* gt = (LAS float*)(St + 48 * PST);
    const bf16* Pm = p.P; bf16* om = (bf16*)p.scr1 + (size_t)2 * T * 512;
    const int bx0 = bid_fresh();
    for (int item = bx0 >= first_block ? bx0 - first_block : 128; item < 128; item += nblocks) {
        const int itx = 4 * (((item >> 3) >> 2) * 8 + (item & 7)) + ((item >> 3) & 3);
        const int sl = itx & 3, d = (itx >> 2) & 1, h = (itx >> 3) & 3, b = itx >> 5;
        const float ibias = p.ml_i_bias[d * 4 + h], fbias = p.ml_f_bias[d * 4 + h];
        f32x4 S[3];
#pragma unroll
        for (int n = 0; n < 3; ++n) S[n] = (f32x4){0.f, 0.f, 0.f, 0.f};
        asm volatile("" : "+v"(S[0]), "+v"(S[1]), "+v"(S[2]));
        __syncthreads();
        for (int i = tid; i < 2 * (64 * PV + 8 * TRSKEW); i += NTHR) Vs[i] = (bf16)0;
        v4u A_rq0, A_rq1, A_rk0, A_rk1, A_rv, B_rq0, B_rq1, B_rk0, B_rk1, B_rv; unsigned short A_rgi, A_rgf, B_rgi, B_rgf;
        const int mr = tid >> 3, cc = tid & 7, ir = d ? 63 - mr : mr;
        const int mg = d ? 63 - lane : lane;
#define ML_LOAD(jj, X) do { const bf16* row_ = Pm + (size_t)(b * TPB + 64 * (jj) + mr) * LDP0; \
            X##rq0 = *(const v4u*)(row_ + C_MQ + h * 128 + 8 * cc); X##rq1 = *(const v4u*)(row_ + C_MQ + h * 128 + 64 + 8 * cc); \
            X##rk0 = *(const v4u*)(row_ + C_MK + h * 128 + 8 * cc); X##rk1 = *(const v4u*)(row_ + C_MK + h * 128 + 64 + 8 * cc); \
            if (cc < 4) X##rv = *(const v4u*)(row_ + C_MV + h * 128 + sl * 32 + 8 * cc); \
            if (w == 1) { const bf16* rg_ = Pm + (size_t)(b * TPB + 64 * (jj) + mg) * LDP0; X##rgi = rg_[C_IG + d * 4 + h]; X##rgf = rg_[C_FG + d * 4 + h]; } } while (0)
#define ML_GATES(gi_, gf_, tab_) do { const float li_ = bf2f(gi_) + ibias; float bc_ = -softplusf_(-(bf2f(gf_) + fbias)); \
            _Pragma("unroll") for (int o_ = 1; o_ < 64; o_ <<= 1) { const float t_ = __shfl_up(bc_, o_); if (lane >= o_) bc_ += t_; } \
            const float b63_ = __shfl(bc_, 63); (tab_)[lane] = bc_; (tab_)[64 + lane] = li_; (tab_)[128 + lane] = __expf(b63_ - bc_ + li_); } while (0)
        ML_LOAD(chunk_of_step(0, d), A_); ML_LOAD(chunk_of_step(1, d), B_);
        if (w == 1) ML_GATES(A_rgi, A_rgf, gt);
#define ML_STEP(j, X, Y) do { \
            const int jj = chunk_of_step(j, d); \
            LAS float* g0 = gt + ((j) & 1) * 192; \
            LDS_BARRIER(); \
            { \
                const float wend = g0[128 + ir]; \
                const unsigned ka[4] = {X##rk0.x, X##rk0.y, X##rk0.z, X##rk0.w}, kb[4] = {X##rk1.x, X##rk1.y, X##rk1.z, X##rk1.w}, va[4] = {X##rv.x, X##rv.y, X##rv.z, X##rv.w}; \
                unsigned ok0[4], ok1[4], ov[4]; \
_Pragma("unroll") \
                for (int u = 0; u < 4; ++u) { \
                    ok0[u] = pk2(bflo(ka[u]) * 0.08838834764831845f, bfhi(ka[u]) * 0.08838834764831845f); ok1[u] = pk2(bflo(kb[u]) * 0.08838834764831845f, bfhi(kb[u]) * 0.08838834764831845f); \
                    ov[u] = pk2(bflo(va[u]) * wend, bfhi(va[u]) * wend); \
                } \
                *(LAS v4u*)(Qs + ir * PQ + 8 * cc) = X##rq0; *(LAS v4u*)(Qs + ir * PQ + 64 + 8 * cc) = X##rq1; \
                *(LAS v4u*)(Ks + ir * PQ + 8 * cc) = (v4u){ok0[0], ok0[1], ok0[2], ok0[3]}; *(LAS v4u*)(Ks + ir * PQ + 64 + 8 * cc) = (v4u){ok1[0], ok1[1], ok1[2], ok1[3]}; \
                if (cc < 4) { *(LAS v4u*)(Vs + ir * PV + (ir >> 3) * TRSKEW + 8 * cc) = X##rv; *(LAS v4u*)(Vts + ir * PV + (ir >> 3) * TRSKEW + 8 * cc) = (v4u){ov[0], ov[1], ov[2], ov[3]}; } \
                if (cc == 4) { Vs[ir * PV + (ir >> 3) * TRSKEW + 32] = (bf16)0x3F80u; Vts[ir * PV + (ir >> 3) * TRSKEW + 32] = (bf16)f2bf(wend); } \
_Pragma("unroll") \
                for (int n = 0; n < 3; ++n) { v2u o; o.x = pk2(S[n][0], S[n][1]); o.y = pk2(S[n][2], S[n][3]); *(LAS v2u*)(St + (16 * n + r16) * PST + 16 * w + 4 * q4) = o; } \
            } \
            LDS_BARRIER(); \
            if (w == 1) ML_GATES(Y##rgi, Y##rgf, gt + (((j) + 1) & 1) * 192); \
            if (j + 2 < 68) ML_LOAD(chunk_of_step(j + 2, d), X); \
            const int ct = w >> 1, h2 = (w & 1) * 2; \
            bf16x8 qf[4]; \
_Pragma("unroll") \
            for (int ks = 0; ks < 4; ++ks) qf[ks] = ldfrag(Qs, PQ, 16 * ct, 32 * ks, lane); \
            { \
                f32x4 a0 = {0.f, 0.f, 0.f, 0.f}, a1 = {0.f, 0.f, 0.f, 0.f}; \
                if (h2 <= ct) { \
_Pragma("unroll") \
                    for (int ks = 0; ks < 4; ++ks) { const bf16x8 a = qf[ks]; a0 = MFMA16(ldfrag(Ks, PQ, 16 * h2, 32 * ks, lane), a, a0); a1 = MFMA16(ldfrag(Ks, PQ, 16 * (h2 + 1), 32 * ks, lane), a, a1); } \
                } \
                const int c = 16 * ct + r16; const float bcr = g0[c]; \
_Pragma("unroll") \
                for (int n = 0; n < 2; ++n) { const f32x4 a = n ? a1 : a0; float o[4]; \
_Pragma("unroll") \
                    for (int i = 0; i < 4; ++i) { const int s = 16 * (h2 + n) + 4 * q4 + i; o[i] = c >= s ? a[i] * __expf(bcr - g0[s] + g0[64 + s]) : 0.f; } \
                    v2u pk; pk.x = pk2(o[0], o[1]); pk.y = pk2(o[2], o[3]); *(LAS v2u*)(Ps + c * PP + 16 * (h2 + n) + 4 * q4) = pk; } \
            } \
            const int hv = w & 1; \
            f32x4 b0 = {0.f, 0.f, 0.f, 0.f}, b1 = {0.f, 0.f, 0.f, 0.f}; \
_Pragma("unroll") \
            for (int ks = 0; ks < 4; ++ks) { const bf16x8 a = qf[ks]; b0 = MFMA16(ldfrag(St, PST, 16 * hv, 32 * ks, lane), a, b0); b1 = MFMA16(ldfrag(St, PST, 32, 32 * ks, lane), a, b1); } \
            LDS_BARRIER(); \
            { \
                f32x4 a0 = {0.f, 0.f, 0.f, 0.f}, a1 = {0.f, 0.f, 0.f, 0.f}; \
_Pragma("unroll") \
                for (int ks = 0; ks < 2; ++ks) { const bf16x8 a = ldfrag(Ps, PP, 16 * ct, 32 * ks, lane); a0 = MFMA16(ldfrag_trs(Vs, PV, 16 * hv, 32 * ks, lane), a, a0); a1 = MFMA16(ldfrag_trs(Vs, PV, 32, 32 * ks, lane), a, a1); } \
                const int c = 16 * ct + r16, mm = d ? 63 - c : c; const float eb = __expf(g0[c]); \
                const float den_l = a1[0] + eb * b1[0]; \
                const float den = fmaxf(fabsf(__shfl(den_l, r16)), 1.f), rd = __builtin_amdgcn_rcpf(den); \
                bf16* orow = om + ((size_t)d * T + b * TPB + 64 * jj + mm) * 512 + h * 128 + sl * 32 + 16 * hv + 4 * q4; \
                v2u o; o.x = pk2((a0[0] + eb * b0[0]) * rd, (a0[1] + eb * b0[1]) * rd); o.y = pk2((a0[2] + eb * b0[2]) * rd, (a0[3] + eb * b0[3]) * rd); \
                *(v2u*)orow = o; \
            } \
            { \
                const float e63 = __expf(g0[63]); \
_Pragma("unroll") \
                for (int n = 0; n < 3; ++n) S[n] = S[n] * e63; \
_Pragma("unroll") \
                for (int ks = 0; ks < 2; ++ks) { const bf16x8 a = ldfrag_tr(Ks, PQ, 16 * w, 32 * ks, lane); \
_Pragma("unroll") \
                    for (int n = 0; n < 3; ++n) S[n] = MFMA16(a, ldfrag_trs(Vts, PV, 16 * n, 32 * ks, lane), S[n]); } \
            } \
} while (0)
        for (int j = 0; j < 68; j += 2) { ML_STEP(j, A_, B_); ML_STEP(j + 1, B_, A_); }
#undef ML_LOAD
#undef ML_GATES
    }
}

constexpr size_t GDN_REC = 2 * 4 * NB * 68;
struct GdnBufs { bf16 *W, *UT, *Qd, *KdT, *QKm; float* cd; };
__device__ __forceinline__ GdnBufs gdn_bufs(CP p) { GdnBufs g; bf16* base = (bf16*)p.scr0; g.W = base; g.UT = g.W + GDN_REC * 8192; g.Qd = g.UT + GDN_REC * 8192; g.KdT = g.Qd + GDN_REC * 8192; g.QKm = g.KdT + GDN_REC * 8192; g.cd = (float*)(g.QKm + GDN_REC * 4096); return g; }

__device__ __forceinline__ void ph_gdn_local(CP p, LAS unsigned char* lds) {
    constexpr int PQ = 136;
    LAS bf16* Qs = (LAS bf16*)lds;
    LAS bf16* Ks = Qs + 64 * PQ;
    LAS bf16* Vs = Ks + 64 * PQ;
    LAS float* Ls = (LAS float*)(Vs + 64 * PQ);
    LAS bf16* Wst = (LAS bf16*)(Ls + 2 * 64 * 68);
    LAS float* ssq = (LAS float*)(Wst + 2 * 64 * PQ);
    LAS float* sg = ssq + 2 * 64 * 8;
    LAS float* scu = sg + 128;
    LAS float* scw = scu + 128;
    const GdnBufs gb = gdn_bufs(p);
    const bf16* Pm = p.P; const float* cw = p.ev_conv_w;
    for (int unit = bid_fresh(); unit < NB * 68 * 4; unit += gridDim.x) {
        const int tid = tid_fresh(), lane = tid & 63, w = __builtin_amdgcn_readfirstlane(tid >> 6), r16 = lane & 15, q4 = lane >> 4;
        const int h = unit & 3, bj = unit >> 2, jj = bj % 68, b = bj / 68;
        const int m = tid >> 3, cc = tid & 7, t = b * TPB + 64 * jj + m;
        const bool hp = (m > 0) || (jj > 0 && jj < 4), hn = (m < 63) || (jj < 3);
        LDS_BARRIER();
        for (int i = tid; i < 2 * 64 * 68; i += NTHR) Ls[i] = 0.f;
        float y[6][8];
#pragma unroll
        for (int ck = 0; ck < 6; ++ck) {
            const int col = (ck >> 1) * 512 + h * 128 + (ck & 1) * 64 + 8 * cc;
            const bf16* pc = Pm + (size_t)t * LDP0 + col;
            const v4u u1 = *(const v4u*)pc; v4u u0 = {0u, 0u, 0u, 0u}, u2 = {0u, 0u, 0u, 0u};
            if (hp) u0 = *(const v4u*)(pc - LDP0);
            if (hn) u2 = *(const v4u*)(pc + LDP0);
            const f32x4* w0 = (const f32x4*)(cw + col), *w1 = (const f32x4*)(cw + 1536 + col), *w2 = (const f32x4*)(cw + 3072 + col);
            const f32x4 w0a = w0[0], w0b = w0[1], w1a = w1[0], w1b = w1[1], w2a = w2[0], w2b = w2[1];
            const unsigned a0[4] = {u0.x, u0.y, u0.z, u0.w}, a1[4] = {u1.x, u1.y, u1.z, u1.w}, a2[4] = {u2.x, u2.y, u2.z, u2.w};
            const float wt0[8] = {w0a.x, w0a.y, w0a.z, w0a.w, w0b.x, w0b.y, w0b.z, w0b.w}, wt1[8] = {w1a.x, w1a.y, w1a.z, w1a.w, w1b.x, w1b.y, w1b.z, w1b.w}, wt2[8] = {w2a.x, w2a.y, w2a.z, w2a.w, w2b.x, w2b.y, w2b.z, w2b.w};
#pragma unroll
            for (int u = 0; u < 4; ++u) {
                y[ck][2 * u] = siluf_(wt0[2 * u] * bflo(a0[u]) + wt1[2 * u] * bflo(a1[u]) + wt2[2 * u] * bflo(a2[u]));
                y[ck][2 * u + 1] = siluf_(wt0[2 * u + 1] * bfhi(a0[u]) + wt1[2 * u + 1] * bfhi(a1[u]) + wt2[2 * u + 1] * bfhi(a2[u]));
            }
        }
        {
            float sq = 0.f, sk = 0.f;
#pragma unroll
            for (int e = 0; e < 8; ++e) { sq += y[0][e] * y[0][e] + y[1][e] * y[1][e]; sk += y[2][e] * y[2][e] + y[3][e] * y[3][e]; }
#pragma unroll
            for (int o = 1; o < 8; o <<= 1) { sq += __shfl_xor(sq, o); sk += __shfl_xor(sk, o); }
            const float rq = rsqrtf(sq + EPS) * 0.08838834764831845f, rk = rsqrtf(sk + EPS);
#pragma unroll
            for (int ck = 0; ck < 6; ++ck) { const float sc = ck < 2 ? rq : (ck < 4 ? rk : 1.f); LAS bf16* dst = (ck < 2 ? Qs : (ck < 4 ? Ks : Vs)) + m * PQ + (ck & 1) * 64 + 8 * cc;
                v4u o; o.x = pk2(y[ck][0] * sc, y[ck][1] * sc); o.y = pk2(y[ck][2] * sc, y[ck][3] * sc); o.z = pk2(y[ck][4] * sc, y[ck][5] * sc); o.w = pk2(y[ck][6] * sc, y[ck][7] * sc);
                *(LAS v4u*)dst = o; }
        }
        if (w < 2) {
            const int d = w, mi = d ? 63 - lane : lane; const bf16* row = Pm + (size_t)(b * TPB + 64 * jj + mi) * LDP0;
            const float la = -__expf(p.gdn_a_log[d * 4 + h]) * softplusf_(bf2f(row[C_AG + d * 4 + h]) + p.gdn_dt_bias[d * 4 + h]);
            const float be = sigmoidf_(bf2f(row[C_BG + d * 4 + h]));
            float g = la;
#pragma unroll
            for (int o = 1; o < 64; o <<= 1) { const float tt = __shfl_up(g, o); if (lane >= o) g += tt; }
            sg[d * 64 + lane] = g; scu[d * 64 + lane] = be; scw[d * 64 + lane] = be * __expf(g);
            if (lane == 63) gb.cd[((size_t)((b * 4 + h) * 2 + d)) * 68 + jj] = __expf(g);
        }
        LDS_BARRIER();
        {
            const int which = w >> 2, ct = w & 3; const LAS bf16* Am = which ? Qs : Ks;
            f32x4 acc[4];
#pragma unroll
            for (int n = 0; n < 4; ++n) acc[n] = (f32x4){0.f, 0.f, 0.f, 0.f};
#pragma unroll
            for (int ks = 0; ks < 4; ++ks) { const bf16x8 a = ldfrag(Am, PQ, 16 * ct, 32 * ks, lane);
#pragma unroll
                for (int n = 0; n < 4; ++n) acc[n] = MFMA16(ldfrag(Ks, PQ, 16 * n, 32 * ks, lane), a, acc[n]); }
            const int cm = 16 * ct + r16;
            const float g0c = sg[cm], g1c = sg[64 + 63 - cm], be0 = scu[cm], be1 = scu[64 + 63 - cm];
#pragma unroll
            for (int n = 0; n < 4; ++n) {
                float v0[4], v1[4];
#pragma unroll
                for (int e = 0; e < 4; ++e) { const int sm = 16 * n + 4 * q4 + e;
                    const float d0 = __expf(g0c - sg[sm]), d1 = __expf(g1c - sg[64 + 63 - sm]);
                    if (which == 0) { if (cm > sm) Ls[(0 * 64 + cm) * 68 + sm] = be0 * acc[n][e] * d0; if (cm < sm) Ls[(1 * 64 + 63 - cm) * 68 + 63 - sm] = be1 * acc[n][e] * d1; }
                    v0[e] = cm >= sm ? acc[n][e] * d0 : 0.f; v1[e] = cm <= sm ? acc[n][e] * d1 : 0.f; }
                if (which == 1) {
                    const size_t r0 = ((size_t)((b * 4 + h) * 2 + 0)) * 68 + jj, r1 = r0 + 68;
                    v2u o0; o0.x = pk2(v0[0], v0[1]); o0.y = pk2(v0[2], v0[3]); *(v2u*)(gb.QKm + r0 * 4096 + cm * 64 + 16 * n + 4 * q4) = o0;
                    v2u o1; o1.x = pk2(v1[3], v1[2]); o1.y = pk2(v1[1], v1[0]); *(v2u*)(gb.QKm + r1 * 4096 + (63 - cm) * 64 + 60 - 16 * n - 4 * q4) = o1;
                }
            }
        }
        LDS_BARRIER();
        {
            LAS float* Ninv = (LAS float*)(lds + GDN_NINV_OFF);
            const int d = w >> 2, wq = w & 3; const LAS float* Ld = Ls + d * 64 * 68;
            {
                const LAS float* Lb = Ld + (16 * wq) * 68 + 16 * wq + r16;
                float lr1 = Lb[68], lr2 = Lb[136], lr3 = Lb[204], lr4 = Lb[272], lr5 = Lb[340], lr6 = Lb[408], lr7 = Lb[476], lr8 = Lb[544], lr9 = Lb[612], lr10 = Lb[680], lr11 = Lb[748], lr12 = Lb[816], lr13 = Lb[884], lr14 = Lb[952], lr15 = Lb[1020];
#define GFM(a_, l_, n_, x_) asm("v_fmac_f32_dpp %0, -%1, %2 row_newbcast:" #n_ " row_mask:0xf bank_mask:0xf" : "+v"(a_) : "v"(l_), "v"(x_))
                float n0 = r16 == 0 ? 1.f : 0.f;
                float n1 = r16 == 1 ? 1.f : 0.f; GFM(n1, lr1, 0, n0);
                float n2 = r16 == 2 ? 1.f : 0.f; GFM(n2, lr2, 0, n0); GFM(n2, lr2, 1, n1);
                float n3 = r16 == 3 ? 1.f : 0.f; GFM(n3, lr3, 0, n0); GFM(n3, lr3, 1, n1); GFM(n3, lr3, 2, n2);
                float n4 = r16 == 4 ? 1.f : 0.f; GFM(n4, lr4, 0, n0); GFM(n4, lr4, 1, n1); GFM(n4, lr4, 2, n2); GFM(n4, lr4, 3, n3);
                float n5 = r16 == 5 ? 1.f : 0.f; GFM(n5, lr5, 0, n0); GFM(n5, lr5, 1, n1); GFM(n5, lr5, 2, n2); GFM(n5, lr5, 3, n3); GFM(n5, lr5, 4, n4);
                float n6 = r16 == 6 ? 1.f : 0.f; GFM(n6, lr6, 0, n0); GFM(n6, lr6, 1, n1); GFM(n6, lr6, 2, n2); GFM(n6, lr6, 3, n3); GFM(n6, lr6, 4, n4); GFM(n6, lr6, 5, n5);
                float n7 = r16 == 7 ? 1.f : 0.f; GFM(n7, lr7, 0, n0); GFM(n7, lr7, 1, n1); GFM(n7, lr7, 2, n2); GFM(n7, lr7, 3, n3); GFM(n7, lr7, 4, n4); GFM(n7, lr7, 5, n5); GFM(n7, lr7, 6, n6);
                float n8 = r16 == 8 ? 1.f : 0.f; GFM(n8, lr8, 0, n0); GFM(n8, lr8, 1, n1); GFM(n8, lr8, 2, n2); GFM(n8, lr8, 3, n3); GFM(n8, lr8, 4, n4); GFM(n8, lr8, 5, n5); GFM(n8, lr8, 6, n6); GFM(n8, lr8, 7, n7);
                float n9 = r16 == 9 ? 1.f : 0.f; GFM(n9, lr9, 0, n0); GFM(n9, lr9, 1, n1); GFM(n9, lr9, 2, n2); GFM(n9, lr9, 3, n3); GFM(n9, lr9, 4, n4); GFM(n9, lr9, 5, n5); GFM(n9, lr9, 6, n6); GFM(n9, lr9, 7, n7); GFM(n9, lr9, 8, n8);
                float n10 = r16 == 10 ? 1.f : 0.f; GFM(n10, lr10, 0, n0); GFM(n10, lr10, 1, n1); GFM(n10, lr10, 2, n2); GFM(n10, lr10, 3, n3); GFM(n10, lr10, 4, n4); GFM(n10, lr10, 5, n5); GFM(n10, lr10, 6, n6); GFM(n10, lr10, 7, n7); GFM(n10, lr10, 8, n8); GFM(n10, lr10, 9, n9);
                float n11 = r16 == 11 ? 1.f : 0.f; GFM(n11, lr11, 0, n0); GFM(n11, lr11, 1, n1); GFM(n11, lr11, 2, n2); GFM(n11, lr11, 3, n3); GFM(n11, lr11, 4, n4); GFM(n11, lr11, 5, n5); GFM(n11, lr11, 6, n6); GFM(n11, lr11, 7, n7); GFM(n11, lr11, 8, n8); GFM(n11, lr11, 9, n9); GFM(n11, lr11, 10, n10);
                float n12 = r16 == 12 ? 1.f : 0.f; GFM(n12, lr12, 0, n0); GFM(n12, lr12, 1, n1); GFM(n12, lr12, 2, n2); GFM(n12, lr12, 3, n3); GFM(n12, lr12, 4, n4); GFM(n12, lr12, 5, n5); GFM(n12, lr12, 6, n6); GFM(n12, lr12, 7, n7); GFM(n12, lr12, 8, n8); GFM(n12, lr12, 9, n9); GFM(n12, lr12, 10, n10); GFM(n12, lr12, 11, n11);
                float n13 = r16 == 13 ? 1.f : 0.f; GFM(n13, lr13, 0, n0); GFM(n13, lr13, 1, n1); GFM(n13, lr13, 2, n2); GFM(n13, lr13, 3, n3); GFM(n13, lr13, 4, n4); GFM(n13, lr13, 5, n5); GFM(n13, lr13, 6, n6); GFM(n13, lr13, 7, n7); GFM(n13, lr13, 8, n8); GFM(n13, lr13, 9, n9); GFM(n13, lr13, 10, n10); GFM(n13, lr13, 11, n11); GFM(n13, lr13, 12, n12);
                float n14 = r16 == 14 ? 1.f : 0.f; GFM(n14, lr14, 0, n0); GFM(n14, lr14, 1, n1); GFM(n14, lr14, 2, n2); GFM(n14, lr14, 3, n3); GFM(n14, lr14, 4, n4); GFM(n14, lr14, 5, n5); GFM(n14, lr14, 6, n6); GFM(n14, lr14, 7, n7); GFM(n14, lr14, 8, n8); GFM(n14, lr14, 9, n9); GFM(n14, lr14, 10, n10); GFM(n14, lr14, 11, n11); GFM(n14, lr14, 12, n12); GFM(n14, lr14, 13, n13);
                float n15 = r16 == 15 ? 1.f : 0.f; GFM(n15, lr15, 0, n0); GFM(n15, lr15, 1, n1); GFM(n15, lr15, 2, n2); GFM(n15, lr15, 3, n3); GFM(n15, lr15, 4, n4); GFM(n15, lr15, 5, n5); GFM(n15, lr15, 6, n6); GFM(n15, lr15, 7, n7); GFM(n15, lr15, 8, n8); GFM(n15, lr15, 9, n9); GFM(n15, lr15, 10, n10); GFM(n15, lr15, 11, n11); GFM(n15, lr15, 12, n12); GFM(n15, lr15, 13, n13); GFM(n15, lr15, 14, n14);
#undef GFM
                if (lane < 16) { LAS float* nd = Ninv + ((d * 4 + wq) * 16) * 16 + lane; nd[0] = n0; nd[16] = n1; nd[32] = n2; nd[48] = n3; nd[64] = n4; nd[80] = n5; nd[96] = n6; nd[112] = n7; nd[128] = n8; nd[144] = n9; nd[160] = n10; nd[176] = n11; nd[192] = n12; nd[208] = n13; nd[224] = n14; nd[240] = n15; }
            }
            LDS_BARRIER();
            const bool isw = wq >= 2;
            const LAS bf16* srcb = (isw ? Ks + 64 * (wq - 2) : Vs + 64 * wq) + r16; const LAS float* cfb = (isw ? scw : scu) + d * 64;
            f32x4 XB[4][4];
#pragma unroll
            for (int kb = 0; kb < 4; ++kb) {
                f32x4 Tt[4];
                { const f32x4 cf4 = *(const LAS f32x4*)(cfb + 16 * kb + 4 * q4);
#pragma unroll
                  for (int v = 0; v < 4; ++v) { const int row = 16 * kb + 4 * q4 + v, mi = d ? 63 - row : row;
#pragma unroll
                      for (int tt = 0; tt < 4; ++tt) Tt[tt][v] = cf4[v] * bf2f(srcb[mi * PQ + 16 * tt]); } }
#pragma unroll
                for (int kc = 0; kc < kb; ++kc) { const f32x4 a4 = *(const LAS f32x4*)(Ld + (16 * kb + r16) * 68 + 16 * kc + 4 * q4);
#pragma unroll
                    for (int s = 0; s < 4; ++s) { const float an = -a4[s];
#pragma unroll
                        for (int tt = 0; tt < 4; ++tt) Tt[tt] = __builtin_amdgcn_mfma_f32_16x16x4f32(an, XB[tt][kc][s], Tt[tt], 0, 0, 0); } }
                { const f32x4 n4 = *(const LAS f32x4*)(Ninv + ((d * 4 + kb) * 16 + r16) * 16 + 4 * q4);
#pragma unroll
                  for (int tt = 0; tt < 4; ++tt) { f32x4 acc = {0.f, 0.f, 0.f, 0.f};
#pragma unroll
                      for (int s = 0; s < 4; ++s) acc = __builtin_amdgcn_mfma_f32_16x16x4f32(n4[s], Tt[tt][s], acc, 0, 0, 0);
                      XB[tt][kb] = acc; } }
            }
            const size_t rec = ((size_t)((b * 4 + h) * 2 + d)) * 68 + jj;
#pragma unroll
            for (int tt = 0; tt < 4; ++tt)
#pragma unroll
                for (int kb = 0; kb < 4; ++kb) { const f32x4 x = XB[tt][kb];
                    if (!isw) { v2u o; o.x = pk2(x[0], x[1]); o.y = pk2(x[2], x[3]); *(v2u*)(gb.UT + rec * 8192 + (size_t)(64 * wq + 16 * tt + r16) * 64 + 16 * kb + 4 * q4) = o; }
                    else { LAS bf16* dst = Wst + d * 64 * PQ + (16 * kb + 4 * q4) * PQ + 64 * (wq - 2) + 16 * tt + r16; dst[0] = (bf16)f2bf(x[0]); dst[PQ] = (bf16)f2bf(x[1]); dst[2 * PQ] = (bf16)f2bf(x[2]); dst[3 * PQ] = (bf16)f2bf(x[3]); } }
        }
        LDS_BARRIER();
        for (int idx = tid; idx < 2 * 64 * 16; idx += NTHR) {
            const int d = idx >> 10, i = (idx >> 4) & 63, ch = idx & 15, mi = d ? 63 - i : i;
            const size_t rec = ((size_t)((b * 4 + h) * 2 + d)) * 68 + jj;
            *(v4u*)(gb.W + rec * 8192 + i * 128 + 8 * ch) = *(const LAS v4u*)(Wst + (d * 64 + i) * PQ + 8 * ch);
            const v4u qv = *(const LAS v4u*)(Qs + mi * PQ + 8 * ch); const float eg = __expf(sg[d * 64 + i]);
            v4u o; o.x = pk2(bflo(qv.x) * eg, bfhi(qv.x) * eg); o.y = pk2(bflo(qv.y) * eg, bfhi(qv.y) * eg); o.z = pk2(bflo(qv.z) * eg, bfhi(qv.z) * eg); o.w = pk2(bflo(qv.w) * eg, bfhi(qv.w) * eg);
            *(v4u*)(gb.Qd + rec * 8192 + i * 128 + 8 * ch) = o;
        }
        for (int idx = tid; idx < 2 * 8 * 128; idx += NTHR) {
            const int d = idx >> 10, ic = (idx >> 7) & 7, dk = idx & 127;
            const size_t rec = ((size_t)((b * 4 + h) * 2 + d)) * 68 + jj; const float gl = sg[d * 64 + 63];
            float v[8];
#pragma unroll
            for (int e = 0; e < 8; ++e) { const int i = 8 * ic + e, mi = d ? 63 - i : i; v[e] = bf2f(Ks[mi * PQ + dk]) * __expf(gl - sg[d * 64 + i]); }
            v4u o; o.x = pk2(v[0], v[1]); o.y = pk2(v[2], v[3]); o.z = pk2(v[4], v[5]); o.w = pk2(v[6], v[7]);
            *(v4u*)(gb.KdT + rec * 8192 + dk * 64 + 8 * ic) = o;
        }
    }
}

__device__ __forceinline__ void ph_gdn_seq(CP p, LAS unsigned char* lds, int first_block, int nblocks) {
    const int tid = tid_fresh(), lane = tid & 63, w = __builtin_amdgcn_readfirstlane(tid >> 6), r16 = lane & 15, q4 = lane >> 4;
    LAS bf16* Ws = (LAS bf16*)lds;
    LAS bf16* Qds = Ws + 64 * PQ;
    LAS bf16* Kds = Qds + 64 * PQ;
    LAS bf16* QKs = Kds + 128 * PS;
    LAS bf16* VnT = QKs + 64 * PS;
    LAS bf16* St = VnT + 32 * PS;
    const GdnBufs gb = gdn_bufs(p); bf16* og = (bf16*)p.scr1;
    const int bx0 = bid_fresh();
    for (int item = bx0 >= first_block ? bx0 - first_block : 128; item < 128; item += nblocks) {
        const int itx = 4 * (((item >> 3) >> 2) * 8 + (item & 7)) + ((item >> 3) & 3);
        const int sl = itx & 3, d = (itx >> 2) & 1, h = (itx >> 3) & 3, b = itx >> 5;
        const size_t rec0 = ((size_t)((b * 4 + h) * 2 + d)) * 68;
        f32x4 S[2] = {(f32x4){0.f, 0.f, 0.f, 0.f}, (f32x4){0.f, 0.f, 0.f, 0.f}};
        asm volatile("" : "+v"(S[0]), "+v"(S[1]));
        const int it = w >> 1, vt = w & 1;
        v4u A_rw[2], A_rqd[2], A_rkd[2], A_rqk, B_rw[2], B_rqd[2], B_rkd[2], B_rqk; v2u A_ru, B_ru; float A_rcd, B_rcd;
#define GDN_LOAD(jj, X) do { const unsigned rec_ = (unsigned)rec0 + (unsigned)(jj); \
            _Pragma("unroll") for (int u = 0; u < 2; ++u) { const int ci = tid + 512 * u; X##rw[u] = *(const v4u*)(gb.W + (rec_ * 8192u + (unsigned)ci * 8u)); X##rqd[u] = *(const v4u*)(gb.Qd + (rec_ * 8192u + (unsigned)ci * 8u)); X##rkd[u] = *(const v4u*)(gb.KdT + (rec_ * 8192u + (unsigned)ci * 8u)); } \
            X##rqk = *(const v4u*)(gb.QKm + (rec_ * 4096u + (unsigned)tid * 8u)); \
            X##ru = *(const v2u*)(gb.UT + (rec_ * 8192u + (unsigned)((sl * 32 + 16 * vt + r16) * 64 + 16 * it + 4 * q4))); X##rcd = gb.cd[rec_]; } while (0)
        GDN_LOAD(chunk_of_step(0, d), A_); GDN_LOAD(chunk_of_step(1, d), B_);
#define GDN_STEP(j, X, Y) do { \
            const int jj = chunk_of_step(j, d); \
            LDS_BARRIER(); \
_Pragma("unroll") \
            for (int u = 0; u < 2; ++u) { const int ci = tid + 512 * u; \
                *(LAS v4u*)(Ws + (ci >> 4) * PQ + (ci & 15) * 8) = X##rw[u]; *(LAS v4u*)(Qds + (ci >> 4) * PQ + (ci & 15) * 8) = X##rqd[u]; *(LAS v4u*)(Kds + (ci >> 3) * PS + (ci & 7) * 8) = X##rkd[u]; } \
            *(LAS v4u*)(QKs + (tid >> 3) * PS + (tid & 7) * 8) = X##rqk; \
_Pragma("unroll") \
            for (int n = 0; n < 2; ++n) { v2u o; o.x = pk2(S[n][0], S[n][1]); o.y = pk2(S[n][2], S[n][3]); *(LAS v2u*)(St + (16 * n + r16) * PST + 16 * w + 4 * q4) = o; } \
            const v2u uu = X##ru; const float cd = X##rcd; \
            LDS_BARRIER(); \
            if (j + 2 < 68) GDN_LOAD(chunk_of_step(j + 2, d), X); \
            f32x4 ws = {0.f, 0.f, 0.f, 0.f}, oo = {0.f, 0.f, 0.f, 0.f}; \
_Pragma("unroll") \
            for (int ks = 0; ks < 4; ++ks) { const bf16x8 sfr = ldfrag(St, PST, 16 * vt, 32 * ks, lane); \
                ws = MFMA16(ldfrag(Ws, PQ, 16 * it, 32 * ks, lane), sfr, ws); \
                oo = MFMA16(sfr, ldfrag(Qds, PQ, 16 * it, 32 * ks, lane), oo); } \
            { v2u o; o.x = pk2(bflo(uu.x) - ws[0], bfhi(uu.x) - ws[1]); o.y = pk2(bflo(uu.y) - ws[2], bfhi(uu.y) - ws[3]); *(LAS v2u*)(VnT + (16 * vt + r16) * PS + 16 * it + 4 * q4) = o; } \
            LDS_BARRIER(); \
_Pragma("unroll") \
            for (int ks = 0; ks < 2; ++ks) oo = MFMA16(ldfrag(VnT, PS, 16 * vt, 32 * ks, lane), ldfrag(QKs, PS, 16 * it, 32 * ks, lane), oo); \
            { const int i = 16 * it + r16, mi = d ? 63 - i : i; \
              v2u ob; ob.x = pk2(oo[0], oo[1]); ob.y = pk2(oo[2], oo[3]); *(v2u*)(og + ((size_t)d * T + b * TPB + 64 * jj + mi) * 512 + h * 128 + sl * 32 + 16 * vt + 4 * q4) = ob; } \
_Pragma("unroll") \
            for (int n = 0; n < 2; ++n) S[n] = S[n] * cd; \
_Pragma("unroll") \
            for (int ks = 0; ks < 2; ++ks) { const bf16x8 a = ldfrag(Kds, PS, 16 * w, 32 * ks, lane); \
_Pragma("unroll") \
                for (int n = 0; n < 2; ++n) S[n] = MFMA16(a, ldfrag(VnT, PS, 16 * n, 32 * ks, lane), S[n]); } \
} while (0)
        for (int j = 0; j < 68; j += 2) { GDN_STEP(j, A_, B_); GDN_STEP(j + 1, B_, A_); }
#undef GDN_LOAD
    }
}

__device__ __forceinline__ void ph_merge_even(CP p) {
    const int tid = tid_fresh(), wv = tid >> 6, which = wv >> 2, h = wv & 3, lane = tid & 63, tq = lane >> 4, cq = lane & 15;
    const bf16* o_f = (const bf16*)p.scr1 + (size_t)which * 2 * T * 512 + h * 128 + 8 * cq; const bf16* o_b = o_f + (size_t)T * 512;
    const bf16* gate = p.P + (which ? C_MO : C_Z) + h * 128 + 8 * cq;
    const float* gainp = (which ? p.ml_norm_g + h * 128 : p.gdn_norm_g) + 8 * cq;
    const f32x4 gA = *(const f32x4*)gainp, gB = *(const f32x4*)(gainp + 4);
    const float gain[8] = {gA.x, gA.y, gA.z, gA.w, gB.x, gB.y, gB.z, gB.w};
    bf16* outp = p.merged + which * 512 + h * 128 + 8 * cq;
    v4u nf[2], nb[2], ng[2];
#define ME_LOAD(t0_) do { _Pragma("unroll") for (int u = 0; u < 2; ++u) { const size_t t = (t0_) + 4 * u + tq; nf[u] = *(const v4u*)(o_f + t * 512); nb[u] = *(const v4u*)(o_b + t * 512); ng[u] = *(const v4u*)(gate + t * LDP0); } } while (0)
#define ME_DPP(x_, ctrl_) __builtin_bit_cast(float, __builtin_amdgcn_update_dpp(0, __builtin_bit_cast(int, x_), ctrl_, 0xf, 0xf, true))
    if ((int)blockIdx.x * 8 < T) ME_LOAD(blockIdx.x * 8);
    for (int t0 = blockIdx.x * 8; t0 < T; t0 += gridDim.x * 8) {
        v4u vf[2], vb[2], vg[2];
#pragma unroll
        for (int u = 0; u < 2; ++u) { vf[u] = nf[u]; vb[u] = nb[u]; vg[u] = ng[u]; }
        if (t0 + (int)gridDim.x * 8 < T) ME_LOAD(t0 + gridDim.x * 8);
#pragma unroll
        for (int u = 0; u < 2; ++u) {
            const unsigned fw[4] = {vf[u].x, vf[u].y, vf[u].z, vf[u].w}, bw[4] = {vb[u].x, vb[u].y, vb[u].z, vb[u].w}, gw4[4] = {vg[u].x, vg[u].y, vg[u].z, vg[u].w};
            float a[8], ss = 0.f;
#pragma unroll
            for (int i = 0; i < 4; ++i) { a[2 * i] = bflo(fw[i]) + bflo(bw[i]); a[2 * i + 1] = bfhi(fw[i]) + bfhi(bw[i]); ss += a[2 * i] * a[2 * i] + a[2 * i + 1] * a[2 * i + 1]; }
            ss += ME_DPP(ss, 0xB1); ss += ME_DPP(ss, 0x4E); ss += ME_DPP(ss, 0x141); ss += ME_DPP(ss, 0x140);
            const float rs = rsqrtf(ss * (1.f / 128.f) + EPS);
            unsigned o[4];
#pragma unroll
            for (int i = 0; i < 4; ++i) { const float g0 = bflo(gw4[i]), g1 = bfhi(gw4[i]);
                const float m0 = which ? sigmoidf_(g0) : siluf_(g0), m1 = which ? sigmoidf_(g1) : siluf_(g1);
                o[i] = pk2(a[2 * i] * rs * gain[2 * i] * m0, a[2 * i + 1] * rs * gain[2 * i + 1] * m1); }
            *(v4u*)(outp + (size_t)(t0 + 4 * u + tq) * D) = (v4u){o[0], o[1], o[2], o[3]};
        }
    }
#undef ME_DPP
}
#undef ME_LOAD
constexpr int RA_P = 1032;
__device__ __forceinline__ void ph_norm2_router(CP p, LAS unsigned char* lds, int layer, int dummy = 0) {
    const int tid = tid_fresh(), lane = tid & 63, w = __builtin_amdgcn_readfirstlane(tid >> 6), r16 = lane & 15, q4 = lane >> 4;
    LAS bf16* Ah = (LAS bf16*)lds; LAS bf16* Al = Ah + 16 * RA_P; LAS float* part = (LAS float*)(Al + 16 * RA_P);
    LAS int* lcnt = (LAS int*)(lds + 131072 + 1024);
    if (tid < 64) lcnt[tid] = 0;
    bf16x8 bh[2][4], bl[2][4];
#pragma unroll
    for (int n = 0; n < 2; ++n)
#pragma unroll
        for (int ks = 0; ks < 4; ++ks) { const size_t o = ((size_t)layer * NE + 16 * n + r16) * D + 128 * w + 32 * ks + 8 * q4; bh[n][ks] = *(const bf16x8*)(p.rwh + o); bl[n][ks] = *(const bf16x8*)(p.rwl + o); }
    __syncthreads();
    const float* g = p.norm2_g + layer * D;
    const float* modl = p.mod + (size_t)layer * 5 * 6 * D + 3 * D;
    const float rbias = p.router_b[layer * NE + (lane >> 1)];
    int* cnt = (int*)p.ctl + (layer * NE) * 64 + dummy * 4096; int* asg_e = dummy ? (int*)p.scr2 : p.asg_e; int* asg_pos = dummy ? (int*)p.scr2 + T * 4 : p.asg_pos; float* asg_w = dummy ? p.scr2 + T * 8 : p.asg_w;
    const int NGRP = (layer ? NB * SEQ : T) / 16;
    v2u xn[2][4];
#define RT_TOK(gi_, u_) (layer ? (((gi_) * 16 + 2 * w + (u_)) >> 12) * TPB + CTX + (((gi_) * 16 + 2 * w + (u_)) & 4095) : (gi_) * 16 + 2 * w + (u_))
#define RT_LOAD(gi_) do { _Pragma("unroll") for (int u = 0; u < 2; ++u) { const v2u* x4_ = (const v2u*)((const bf16*)p.xres + (size_t)RT_TOK(gi_, u) * D) + lane; \
        _Pragma("unroll") for (int j = 0; j < 4; ++j) xn[u][j] = x4_[64 * j]; } } while (0)
    if ((int)blockIdx.x < NGRP) RT_LOAD((int)blockIdx.x);
    for (int gi = blockIdx.x; gi < NGRP; gi += gridDim.x) {
        int tt[2]; v2u xc[2][4];
#pragma unroll
        for (int u = 0; u < 2; ++u)
#pragma unroll
            for (int j = 0; j < 4; ++j) xc[u][j] = xn[u][j];
#pragma unroll
        for (int u = 0; u < 2; ++u) {
            const int tl = 2 * w + u, t = RT_TOK(gi, u); tt[u] = t;
            const int r = (t % TPB) < CTX ? 4 : t / TPB;
            const f32x4* g4 = (const f32x4*)g + lane; const f32x4* sh4 = (const f32x4*)(modl + (size_t)r * 6 * D) + lane; const f32x4* sc4 = sh4 + D / 4;
            f32x4 v[4]; float s = 0.f;
#pragma unroll
            for (int j = 0; j < 4; ++j) { const v2u xb = xc[u][j]; v[j] = (f32x4){bflo(xb.x), bfhi(xb.x), bflo(xb.y), bfhi(xb.y)}; s += (v[j].x * v[j].x + v[j].y * v[j].y) + (v[j].z * v[j].z + v[j].w * v[j].w); }
            const float rs = rsqrtf(wave_sum_dpp(s) * (1.f / D) + EPS);
#pragma unroll
            for (int j = 0; j < 4; ++j) { const f32x4 gg = g4[64 * j], sh = sh4[64 * j], sc = sc4[64 * j];
                f32x4 h; h.x = (v[j].x * rs * gg.x) * (1.f + sc.x) + sh.x; h.y = (v[j].y * rs * gg.y) * (1.f + sc.y) + sh.y; h.z = (v[j].z * rs * gg.z) * (1.f + sc.z) + sh.z; h.w = (v[j].w * rs * gg.w) * (1.f + sc.w) + sh.w;
                v2u hi; hi.x = pk2(h.x, h.y); hi.y = pk2(h.z, h.w);
                v2u lo; lo.x = pk2(h.x - bflo(hi.x), h.y - bfhi(hi.x)); lo.y = pk2(h.z - bflo(hi.y), h.w - bfhi(hi.y));
                *(LAS v2u*)(Ah + tl * RA_P + 4 * lane + 256 * j) = hi; *(LAS v2u*)(Al + tl * RA_P + 4 * lane + 256 * j) = lo;
                *(unsigned*)(p.h8 + (size_t)t * D + 4 * lane + 256 * j) = pk4_f8(h.x, h.y, h.z, h.w); }
        }
        if (gi + (int)gridDim.x < NGRP) RT_LOAD(gi + (int)gridDim.x);
        LDS_BARRIER();
        {
            f32x4 acc[2] = {(f32x4){0.f, 0.f, 0.f, 0.f}, (f32x4){0.f, 0.f, 0.f, 0.f}};
#pragma unroll
            for (int ks = 0; ks < 4; ++ks) { const bf16x8 ah = ldfrag(Ah, RA_P, 0, 128 * w + 32 * ks, lane), al = ldfrag(Al, RA_P, 0, 128 * w + 32 * ks, lane);
#pragma unroll
                for (int n = 0; n < 2; ++n) { acc[n] = MFMA16(ah, bh[n][ks], acc[n]); acc[n] = MFMA16(ah, bl[n][ks], acc[n]); acc[n] = MFMA16(al, bh[n][ks], acc[n]); } }
#pragma unroll
            for (int n = 0; n < 2; ++n)
#pragma unroll
                for (int i = 0; i < 4; ++i) part[(w * 16 + 4 * q4 + i) * 33 + 16 * n + r16] = acc[n][i];
        }
        LDS_BARRIER();
        {
            int ln = lane; asm volatile("" : "+v"(ln));
            const int tk = ln >> 5, myidx = ln & 31, tl = 2 * w + tk, t = tk ? tt[1] : tt[0];
            float lg = p.router_b[layer * NE + myidx];
#pragma unroll
            for (int ww = 0; ww < 8; ++ww) lg += part[(ww * 16 + tl) * 33 + myidx];
#define RT_DPPF(x_, c_) __builtin_bit_cast(float, __builtin_amdgcn_update_dpp(0, __builtin_bit_cast(int, x_), c_, 0xf, 0xf, true))
#define RT_DPPI(x_, c_) __builtin_amdgcn_update_dpp(0, x_, c_, 0xf, 0xf, true)
#define RT_STEP(ov_, oi_) do { const float ov = (ov_); const int oi = (oi_); const bool take = (ov > bv) || (ov == bv && oi < bi); bv = take ? ov : bv; bi = take ? oi : bi; } while (0)
            float tv[4]; int ti[4];
#pragma unroll
            for (int k = 0; k < 4; ++k) {
                float bv = lg; int bi = myidx;
                RT_STEP(RT_DPPF(bv, 0xB1), RT_DPPI(bi, 0xB1)); RT_STEP(RT_DPPF(bv, 0x4E), RT_DPPI(bi, 0x4E)); RT_STEP(RT_DPPF(bv, 0x141), RT_DPPI(bi, 0x141)); RT_STEP(RT_DPPF(bv, 0x140), RT_DPPI(bi, 0x140));
                RT_STEP(shflx(bv, 16, ln), shflxi(bi, 16, ln));
                tv[k] = bv; ti[k] = bi; if (myidx == bi) lg = -INFINITY;
            }
#undef RT_STEP
#undef RT_DPPI
#undef RT_DPPF
            float ex[4], den = 0.f;
#pragma unroll
            for (int k = 0; k < 4; ++k) { ex[k] = __expf(tv[k] - tv[0]); den += ex[k]; }
            if (myidx < 4) {
                int e = ti[0]; float wgt = ex[0];
#pragma unroll
                for (int k = 1; k < 4; ++k) if (myidx == k) { e = ti[k]; wgt = ex[k]; }
                const int pos = __hip_atomic_fetch_add(&lcnt[e], 1, __ATOMIC_RELAXED, __HIP_MEMORY_SCOPE_WORKGROUP);
                asg_e[t * 4 + myidx] = e; asg_pos[t * 4 + myidx] = pos; asg_w[t * 4 + myidx] = wgt * __builtin_amdgcn_rcpf(den);
            }
        }
    }
#undef RT_LOAD
    __syncthreads();
    if (tid < NE) lcnt[NE + tid] = atomicAdd(&cnt[tid * 64], lcnt[tid]);
    __syncthreads();
    unsigned char* hs8 = dummy ? (unsigned char*)p.scr1 : (unsigned char*)p.hs;
    int ce_[2], cp_[2]; unsigned long long c0_[2], c1_[2];
#define CPY_LOAD(gi_) do { _Pragma("unroll") for (int u = 0; u < 2; ++u) { const int t_ = RT_TOK(gi_, u); ce_[u] = 0; cp_[u] = 0; if (lane < 4) { ce_[u] = asg_e[t_ * 4 + lane]; cp_[u] = asg_pos[t_ * 4 + lane]; } \
        const unsigned long long* src_ = (const unsigned long long*)(p.h8 + (size_t)t_ * D) + 2 * lane; \
        c0_[u] = __hip_atomic_load(src_, __ATOMIC_RELAXED, __HIP_MEMORY_SCOPE_AGENT); c1_[u] = __hip_atomic_load(src_ + 1, __ATOMIC_RELAXED, __HIP_MEMORY_SCOPE_AGENT); } } while (0)
    if ((int)blockIdx.x < NGRP) CPY_LOAD((int)blockIdx.x);
    for (int gi = blockIdx.x; gi < NGRP; gi += gridDim.x) {
        int e_[2], pr_[2]; unsigned long long v0_[2], v1_[2];
#pragma unroll
        for (int u = 0; u < 2; ++u) { e_[u] = ce_[u]; pr_[u] = cp_[u]; v0_[u] = c0_[u]; v1_[u] = c1_[u]; }
        if (gi + (int)gridDim.x < NGRP) CPY_LOAD(gi + (int)gridDim.x);
#pragma unroll
        for (int u = 0; u < 2; ++u) { const int t = RT_TOK(gi, u);
            int pos = 0;
            if (lane < 4) { pos = pr_[u] + lcnt[NE + e_[u]]; asg_pos[t * 4 + lane] = pos; }
#pragma unroll
            for (int k = 0; k < 4; ++k) { const int ek = __shfl(e_[u], k), pk = __shfl(pos, k);
                unsigned long long* dst = (unsigned long long*)(hs8 + ((size_t)ek * T + pk) * D) + 2 * lane; dst[0] = v0_[u]; dst[1] = v1_[u]; } }
    }
#undef CPY_LOAD
}
__device__ __forceinline__ void moe_base_to_lds(CP p, int layer, int* base_gen) {
    {
        const int tid = tid_fresh();
        if (tid < 64) {
            const int* cnt = (const int*)p.ctl + (layer * NE) * 64;
            const int ce = tid < NE ? __hip_atomic_load(cnt + tid * 64, __ATOMIC_RELAXED, __HIP_MEMORY_SCOPE_AGENT) : 0;
            const int pad = (ce + 255) / 256 * 256;
            int incl = pad;
#pragma unroll
            for (int o = 1; o < 32; o <<= 1) { const int t = __shfl_up(incl, o); if (tid >= o) incl += t; }
            if (tid < NE) { base_gen[tid] = incl - pad; base_gen[40 + tid] = ce; }
            if (tid == NE - 1) base_gen[NE] = incl;
        }
    }
    __syncthreads();
    { const int rb = tid_fresh(); if (rb < MOE_ROWS / 256) { int e = 0; for (int k = 1; k < NE; ++k) e = ((rb << 8) >= base_gen[k]) ? k : e; ((unsigned char*)base_gen)[320 + rb] = (unsigned char)e; } }
    __syncthreads();
}
__device__ __forceinline__ void ph_combine(CP p, int layer, const int* base, int dummy = 0) {
    const int tid_ = tid_fresh(), lane = tid_ & 63, gw = (tid_ >> 6) * gridDim.x + blockIdx.x, NGW = gridDim.x * NWAVES;
    const float* modl = p.mod + (size_t)layer * 5 * 6 * D;
    const int NTOK = layer ? NB * SEQ : T;
    int ne_[2][4], np_[2][4]; float nw_[2][4];
#define CMB_TOK(q) (layer ? ((q) >> 12) * TPB + CTX + ((q) & 4095) : (q))
#define CMB_LOAD_ASG(q0_) do { _Pragma("unroll") for (int u = 0; u < 2; ++u) { const int q = (q0_) + u * NGW; const int qq = q < NTOK ? q : (q0_); const int t_ = CMB_TOK(qq); \
        _Pragma("unroll") for (int k = 0; k < 4; ++k) { ne_[u][k] = p.asg_e[t_ * 4 + k]; np_[u][k] = p.asg_pos[t_ * 4 + k]; nw_[u][k] = p.asg_w[t_ * 4 + k]; } } } while (0)
    if (gw < NTOK) CMB_LOAD_ASG(gw);
    for (int q0 = gw; q0 < NTOK; q0 += 2 * NGW) {
        int tt[2], rr[2]; bool ok[2]; int rows[2][4]; float w[2][4];
#pragma unroll
        for (int u = 0; u < 2; ++u) { const int q = q0 + u * NGW; ok[u] = q < NTOK; const int qq = ok[u] ? q : q0; tt[u] = CMB_TOK(qq); rr[u] = (tt[u] % TPB) < CTX ? 4 : tt[u] / TPB;
#pragma unroll
            for (int k = 0; k < 4; ++k) { rows[u][k] = base[ne_[u][k]] + np_[u][k]; w[u][k] = nw_[u][k]; } }
        if (q0 + 2 * NGW < NTOK) CMB_LOAD_ASG(q0 + 2 * NGW);
        f32x4 v[2][4], G[2][4], SH[2][4]; float s[2] = {0.f, 0.f};
#pragma unroll
        for (int u = 0; u < 2; ++u) {
            const v2u* x4 = (const v2u*)((const bf16*)p.xres + (size_t)tt[u] * D) + lane; const f32x4* g24 = (const f32x4*)(modl + (size_t)rr[u] * 6 * D + 5 * D) + lane;
            const f32x4* g4 = (layer == 0 ? (const f32x4*)(p.norm1_g + D) : (const f32x4*)p.final_g) + lane;
            const f32x4* sh4 = (const f32x4*)(p.mod + (size_t)5 * 6 * D + (size_t)rr[u] * 6 * D) + lane; const f32x4* sc4 = sh4 + D / 4;
#pragma unroll
            for (int j = 0; j < 4; ++j) {
                f32x4 acc = {0.f, 0.f, 0.f, 0.f};
                G[u][j] = g4[64 * j]; if (layer == 0) { SH[u][j] = sh4[64 * j]; G[u][j] = G[u][j] * (sc4[64 * j] + 1.f); }
#pragma unroll
                for (int k = 0; k < 4; ++k) { const v2u yv = *((const v2u*)(p.yb + (size_t)rows[u][k] * D) + lane + 64 * j);
                    acc.x += w[u][k] * bflo(yv.x); acc.y += w[u][k] * bfhi(yv.x); acc.z += w[u][k] * bflo(yv.y); acc.w += w[u][k] * bfhi(yv.y); }
                { const v2u xb = x4[64 * j]; v[u][j] = (f32x4){bflo(xb.x), bfhi(xb.x), bflo(xb.y), bfhi(xb.y)} + g24[64 * j] * acc; }
                s[u] += (v[u][j].x * v[u][j].x + v[u][j].y * v[u][j].y) + (v[u][j].z * v[u][j].z + v[u][j].w * v[u][j].w);
            }
        }
#pragma unroll
        for (int u = 0; u < 2; ++u) {
            if (!ok[u]) continue;
            const int t = tt[u];
            const float rs = rsqrtf(wave_sum(s[u]) * (1.f / D) + EPS);
            if (layer == 0) {
#pragma unroll
                for (int j = 0; j < 4; ++j) { { v2u xo; xo.x = pk2(v[u][j].x, v[u][j].y); xo.y = pk2(v[u][j].z, v[u][j].w); *((v2u*)((bf16*)(dummy ? p.scr0 : p.xres) + (size_t)t * D) + lane + 64 * j) = xo; }
                    const f32x4 gg = G[u][j], sh = SH[u][j];
                    v2u o; o.x = pk2((v[u][j].x * rs) * gg.x + sh.x, (v[u][j].y * rs) * gg.y + sh.y); o.y = pk2((v[u][j].z * rs) * gg.z + sh.z, (v[u][j].w * rs) * gg.w + sh.w);
                    *((v2u*)((dummy ? (bf16*)p.scr1 : p.hb) + (size_t)t * D) + lane + 64 * j) = o; }
            } else {
                float* orow = (dummy ? p.scr0 : p.out) + ((size_t)(t / TPB) * SEQ + (t % TPB - CTX)) * D;
#pragma unroll
                for (int j = 0; j < 4; ++j) { const f32x4 gg = G[u][j]; f32x4 o; o.x = v[u][j].x * rs * gg.x; o.y = v[u][j].y * rs * gg.y; o.z = v[u][j].z * rs * gg.z; o.w = v[u][j].w * rs * gg.w; *((f32x4*)orow + lane + 64 * j) = o; }
            }
        }
    }
#undef CMB_TOK
#undef CMB_LOAD_ASG
}

#ifndef REP_PRO
#define REP_PRO 1
#endif
#ifndef REP_GEMM
#define REP_GEMM 1
#endif
#ifndef REP_GDNL
#define REP_GDNL 1
#endif
#ifndef REP_SEQ
#define REP_SEQ 1
#endif
#ifndef REP_ROUTER
#define REP_ROUTER 1
#endif
#ifndef REP_COMB
#define REP_COMB 1
#endif
#ifndef REP_OUT0
#define REP_OUT0 1
#endif
#ifndef REP_GSEQ
#define REP_GSEQ 0
#endif
#ifndef REP_MSEQ
#define REP_MSEQ 0
#endif
#ifndef REP_THIN
#define REP_THIN 1
#endif
#ifndef REP_RET
#define REP_RET 1
#endif
#define REPEAT_0(X)
#define REPEAT_1(X) X
#define REPEAT_2(X) X X
#define REPEAT_N_(n, X) REPEAT_##n(X)
#define REPEAT_N(n, X) REPEAT_N_(n, X)
#define REPEAT_PRO(X) REPEAT_N(REP_PRO, X)
#define REPEAT_GEMM(X) REPEAT_N(REP_GEMM, X)
#define REPEAT_SCAN(X) REPEAT_N(REP_SCAN, X)
constexpr int CTL_BYTES = 65536, BAR_WORD0 = 12288, LDS_MISC = 131072, LDS_BASE = 131072 + 256;
__global__ void __launch_bounds__(NTHR, 2) k_mega(Params p) {
    extern __shared__ __attribute__((aligned(16))) unsigned char lds_raw[];
    LAS unsigned char* lds = (LAS unsigned char*)lds_raw;
    volatile LAS unsigned* misc = (volatile LAS unsigned*)(lds + LDS_MISC);
    if (threadIdx.x < 64) misc[threadIdx.x] = 0u;
    if ((threadIdx.x & 63) == 0) *(volatile LAS int*)(lds + LDS_WAVETAB + 4 * ((unsigned)__builtin_amdgcn_s_getreg((5 << 11) | 4) & 63u)) = (int)(threadIdx.x >> 6);
    __syncthreads();
    (void)xcd_barrier_post((unsigned*)kp_fresh()->ctl + BAR_WORD0, misc);
    int* base_gen = (int*)(lds_raw + LDS_BASE);
#define GRID_BAR() do { XcdBarrier bb; bb.bar = (unsigned*)kp_fresh()->ctl + BAR_WORD0; bb.x = xb_xcc_id(); bb.st = misc; xcd_barrier(bb); } while (0)

#define PH(stmt) do { CP P = *kp_fresh(); stmt; } while (0)
#if defined(REP_BAR)
    for (int rb_ = 0; rb_ < REP_BAR; ++rb_) GRID_BAR();
#endif
    REPEAT_PRO(PH(ph_prologue(P, lds)); GRID_BAR();)
    REPEAT_N(REP_THIN, PH(ph_norm(P, 0, 0)); GRID_BAR();)
#pragma unroll
    for (int layer = 0; layer < 2; ++layer) {
        REPEAT_GEMM(PH(ph_gemm_in(P, lds, layer)); GRID_BAR();)
        if (layer == 0) {
            REPEAT_N(REP_GDNL, PH(ph_gdn_local(P, lds); __syncthreads(); ph_fill(P, lds, FILL_LOCAL)); GRID_BAR();)
            REPEAT_N(REP_SEQ, { const int half = gridDim.x >> 1; PH(ph_gdn_seq(P, lds, 0, half); if ((int)blockIdx.x < half) { __syncthreads(); ph_fill(P, lds, FILL_SEQ); } REPEAT_N(REP_GSEQ, ph_gdn_seq(P, lds, 0, half);) ph_mlstm_scan(P, lds, half, gridDim.x - half); REPEAT_N(REP_MSEQ, ph_mlstm_scan(P, lds, half, gridDim.x - half);) if ((int)blockIdx.x >= half) { __syncthreads(); ph_fill(P, lds, FILL_SEQ); }); GRID_BAR(); })
            REPEAT_N(REP_THIN, PH(ph_merge_even(P)); GRID_BAR();)
        } else {
            REPEAT_N(REP_RET, PH(ph_ret_scan(P, lds)); GRID_BAR();)
            REPEAT_N(REP_THIN, PH(ph_merge_odd(P)); GRID_BAR();)
        }
        PH(ph_gemm_out(P, lds, layer)); GRID_BAR();
#if REP_OUT0 == 2
        if (layer == 0) { PH(ph_gemm_out(P, lds, layer)); GRID_BAR(); }
#endif
        PH(ph_norm2_router(P, lds, layer); if (layer == 1) { __syncthreads(); ph_fill(P, lds, FILL_CATCH); }); GRID_BAR();
#if REP_ROUTER == 2
        PH(ph_norm2_router(P, lds, layer, 1)); GRID_BAR();
#endif
        PH(moe_base_to_lds(P, layer, base_gen));
        REPEAT_GEMM(PH(ph_moe_gu(P, lds, layer, base_gen)); GRID_BAR();)
        REPEAT_GEMM(PH(ph_moe_dn(P, lds, layer, base_gen)); GRID_BAR();)
#if REP_COMB == 2
        PH(ph_combine(P, layer, base_gen, 1)); GRID_BAR();
#endif
        PH(ph_combine(P, layer, base_gen));
        if (layer == 0) GRID_BAR();
    }
}

extern "C" void kernel_launch(void* const* d_in, const int* in_sizes, int n_in, void* d_out, int out_size, void* d_ws, size_t ws_size, hipStream_t stream) {
    Params p{};
    const float** pin = (const float**)&p;
    for (int i = 0; i < 27; ++i) pin[i] = (const float*)d_in[i];
    p.out = (float*)d_out;
    char* ws = (char*)d_ws; size_t off = 0;
    auto take = [&](size_t bytes) { char* q = ws + off; off += (bytes + 255) & ~(size_t)255; return q; };
    p.ctl = (unsigned*)take(CTL_BYTES);
    p.mod = (float*)take((size_t)2 * 5 * 6 * D * 4);
    p.xres = (float*)take((size_t)T * D * 4);
    p.rope = (float*)take((size_t)TPB * 64 * 2 * 4);
    p.od = (bf16*)take((size_t)2 * T * 2048 * 2);
    p.hb = (bf16*)take((size_t)T * D * 2);
    p.P = (bf16*)take((size_t)T * LDP1 * 2);
    p.merged = (bf16*)take((size_t)T * 2048 * 2);
    p.wt_in0 = (bf16*)take((size_t)LDP0 * D * 2); p.wt_out0 = (bf16*)take((size_t)D * D * 2); p.wt_in1 = (bf16*)take((size_t)LDP1 * D * 2); p.wt_out1 = (bf16*)take((size_t)D * 2 * D * 2);
    p.wt_gu = (bf16*)take((size_t)2 * NE * 2 * DFF * D); p.wt_dn = (bf16*)take((size_t)2 * NE * D * DFF);
    p.act = (bf16*)take((size_t)MOE_ROWS * DFF);     p.yb = (bf16*)take((size_t)MOE_ROWS * D * 2);
    p.asg_e = (int*)take((size_t)T * 4 * 4); p.asg_pos = (int*)take((size_t)T * 4 * 4); p.slot_tok = (int*)take((size_t)NE * T * 4); p.h8 = (unsigned char*)take((size_t)T * D); p.rwh = (bf16*)take((size_t)2 * NE * D * 2); p.rwl = (bf16*)take((size_t)2 * NE * D * 2); p.asg_w = (float*)take((size_t)T * 4 * 4);
    p.scr0 = (float*)take((size_t)NE * T * D);
    p.hs = (bf16*)p.scr0;
    p.scr1 = (float*)take((size_t)3 * T * 1024 * 4);
    p.scr2 = (float*)take((size_t)8 * T * 4 * 4);
    static int grid = 0;
    if (!grid) {
        int dev = 0, cus = 0, per_cu = 0;
        if (off > ws_size || n_in != 27) { fprintf(stderr, "kernel_launch: workspace too small or bad inputs: need %zu, have %zu, n_in %d\n", off, ws_size, n_in); grid = -1; }
        else if (hipGetDevice(&dev) != hipSuccess || hipDeviceGetAttribute(&cus, hipDeviceAttributeMultiprocessorCount, dev) != hipSuccess) grid = -1;
        else if (hipFuncSetAttribute((const void*)k_mega, hipFuncAttributeMaxDynamicSharedMemorySize, LDS_BYTES) != hipSuccess) grid = -1;
        else { if (hipOccupancyMaxActiveBlocksPerMultiprocessor(&per_cu, (const void*)k_mega, NTHR, LDS_BYTES) != hipSuccess || per_cu < 1) fprintf(stderr, "kernel_launch: occupancy query says %d blocks per CU\n", per_cu);
               grid = cus; }
        if (grid < 0) fprintf(stderr, "kernel_launch: set-up failed; nothing launched\n");
    }
    if (grid <= 0) return;
    (void)hipMemsetAsync(p.ctl, 0, CTL_BYTES, stream);
    hipLaunchKernelGGL(k_mega, dim3(grid), dim3(NTHR), LDS_BYTES, stream, p);
}
```
